# Optimizing an MI355X kernel written in HIP

```python
import math
import jax, jax.numpy as jnp
from jax import lax
import numpy as np

D_MODEL = 4096
BATCH = 4
SEQ = 2048
DEPTH = 1

D_MIX = D_MODEL
D_ATTN = D_MIX // 2
D_GMLP = D_MIX - D_ATTN
ATTN_HEADS = 8
ATTN_HEAD_DIM = D_ATTN // (2 * ATTN_HEADS)
ATTN_V_DIM = 2 * ATTN_HEAD_DIM
GMLP_HEADS = 8
GMLP_HEAD_DIM = D_GMLP // GMLP_HEADS
CHUNK = 128
Q_BLOCK = 128
D_IN = 3 * D_ATTN + 2 * D_GMLP
REL_BUCKETS = 32
REL_MAX_DIST = 128
N_GROUPS = 8
EXPERTS_PER_GROUP = 8
N_EXPERTS = N_GROUPS * EXPERTS_PER_GROUP
TOP_K = 2
D_FF_EXPERT = 512
MOE_BLOCK = 128
LN_EPS = 1e-5
DN_ALPHA = (2 * DEPTH) ** 0.25
DN_BETA = (8 * DEPTH) ** -0.25
NEG_INF = -1e30

kernel_name = "hybrid_diffattn_gmlp_hiermoe_deepnorm"


def layer_norm(x, g, b):
    xf = x.astype(jnp.float32)
    mu = jnp.mean(xf, axis=-1, keepdims=True)
    var = jnp.mean(jnp.square(xf - mu), axis=-1, keepdims=True)
    return ((xf - mu) * lax.rsqrt(var + LN_EPS) * g.astype(jnp.float32) + b.astype(jnp.float32)).astype(x.dtype)


def rms_norm(x, g):
    xf = x.astype(jnp.float32)
    return (xf * lax.rsqrt(jnp.mean(jnp.square(xf), axis=-1, keepdims=True) + LN_EPS) * g.astype(jnp.float32)).astype(x.dtype)


def rel_bucket(q_pos, k_pos):
    n = jnp.maximum(q_pos[:, None] - k_pos[None, :], 0)
    max_exact = REL_BUCKETS // 2
    nf = jnp.maximum(n, max_exact).astype(jnp.float32)
    large = max_exact + (jnp.log(nf / max_exact) / math.log(REL_MAX_DIST / max_exact)
                         * (REL_BUCKETS - max_exact)).astype(jnp.int32)
    large = jnp.minimum(large, REL_BUCKETS - 1)
    return jnp.where(n < max_exact, n, large)


def diff_attention(q, k, v, lam, lambda_init, subln_g, rel_table):
    B, H, _, S, Dh = q.shape
    nb = S // Q_BLOCK
    scale = ATTN_HEAD_DIM ** -0.5
    k_pos = jnp.arange(S)
    qb = q.reshape(B, H, 2, nb, Q_BLOCK, Dh).transpose(3, 0, 1, 2, 4, 5)

    def block(args):
        i, q_i = args
        q_pos = i * Q_BLOCK + jnp.arange(Q_BLOCK)
        bias = rel_table[rel_bucket(q_pos, k_pos)].transpose(2, 0, 1).astype(jnp.float32)
        s = jnp.einsum('bhmqd,bhmkd->bhmqk', q_i, k).astype(jnp.float32) * scale
        s = s + bias[None, :, None]
        causal = k_pos[None, :] <= q_pos[:, None]
        s = jnp.where(causal, s, NEG_INF)
        p = jax.nn.softmax(s, axis=-1)
        a = p[:, :, 0] - lam * p[:, :, 1]
        return jnp.einsum('bhqk,bhkd->bhqd', a.astype(v.dtype), v)

    out = lax.map(block, (jnp.arange(nb), qb))
    out = out.transpose(1, 0, 3, 2, 4).reshape(B, S, H, ATTN_V_DIM)
    out = rms_norm(out, subln_g) * (1.0 - lambda_init)
    return out.reshape(B, S, H * ATTN_V_DIM)


def chunked_spatial_gating(u, g, ln_g, ln_b, w_s, b_s):
    B, S, _ = u.shape
    u = jax.nn.gelu(u, approximate=False)
    v = layer_norm(jax.nn.gelu(g, approximate=False), ln_g, ln_b)
    vc = v.reshape(B, S // CHUNK, CHUNK, GMLP_HEADS, GMLP_HEAD_DIM)
    tril = jnp.tril(jnp.ones((CHUNK, CHUNK), dtype=bool))
    ws = jnp.where(tril[None], w_s, 0)
    mixed = jnp.einsum('hts,bcshd->bcthd', ws, vc) + b_s.T[None, None, :, :, None]
    return u * mixed.reshape(B, S, D_GMLP)


def hierarchical_moe(x, w_group, b_group, w_expert, b_expert, w_gate, w_up, w_down):
    B, S, D = x.shape
    N = B * S
    xf = x.reshape(N, D)
    g_logits = (xf @ w_group + b_group).astype(jnp.float32)
    g_prob = jax.nn.softmax(g_logits, axis=-1)
    g_idx = jnp.argmax(g_logits, axis=-1)
    g_w = jnp.take_along_axis(g_prob, g_idx[:, None], axis=-1)
    e_logits = (jnp.einsum('nd,dge->nge', xf, w_expert) + b_expert).astype(jnp.float32)
    e_logits = jnp.take_along_axis(e_logits, g_idx[:, None, None], axis=1)[:, 0]
    e_top, e_idx = lax.top_k(e_logits, TOP_K)
    e_w = jax.nn.softmax(e_top, axis=-1)
    weights = (g_w * e_w).reshape(-1)
    expert_id = (g_idx[:, None] * EXPERTS_PER_GROUP + e_idx).reshape(-1).astype(jnp.int32)
    token_id = jnp.repeat(jnp.arange(N, dtype=jnp.int32), TOP_K)
    A = N * TOP_K
    order = jnp.argsort(expert_id)
    s_eid = expert_id[order]
    s_tok = token_id[order]
    s_w = weights[order]
    counts = jnp.bincount(expert_id, length=N_EXPERTS)
    starts = jnp.cumsum(counts) - counts
    padded = (counts + MOE_BLOCK - 1) // MOE_BLOCK * MOE_BLOCK
    pad_ends = jnp.cumsum(padded)
    pad_starts = pad_ends - padded
    n_blocks = -(-A // MOE_BLOCK) + N_EXPERTS
    dest = pad_starts[s_eid] + (jnp.arange(A) - starts[s_eid])
    tok_pad = jnp.full((n_blocks * MOE_BLOCK,), N, jnp.int32).at[dest].set(s_tok)
    w_pad = jnp.zeros((n_blocks * MOE_BLOCK,), jnp.float32).at[dest].set(s_w)
    block_expert = jnp.minimum(
        jnp.searchsorted(pad_ends, jnp.arange(n_blocks) * MOE_BLOCK, side='right'), N_EXPERTS - 1)
    x_pad = jnp.concatenate([xf, jnp.zeros((1, D), xf.dtype)], axis=0)

    def expert_block(args):
        tok, e = args
        xb = x_pad[tok]
        h = jax.nn.silu(xb @ w_gate[e]) * (xb @ w_up[e])
        return h @ w_down[e]

    out = lax.map(expert_block, (tok_pad.reshape(n_blocks, MOE_BLOCK), block_expert))
    out = out.reshape(-1, D) * w_pad[:, None].astype(out.dtype)
    y = jnp.zeros((N + 1, D), out.dtype).at[tok_pad].add(out)[:N]
    return y.reshape(B, S, D)


def setup_inputs(seed: int = 0) -> dict:
    key = jax.random.key(seed)
    ks = jax.random.split(key, 26)
    n = lambda k, shape, s: jax.random.normal(k, shape, jnp.float32) * s
    return {
        "x": n(ks[0], (BATCH, SEQ, D_MODEL), 1.0),
        "w_in": n(ks[1], (DEPTH, D_MODEL, D_IN), D_MODEL ** -0.5),
        "w_out": n(ks[2], (DEPTH, D_MIX, D_MODEL), D_MIX ** -0.5 * DN_BETA),
        "lambda_q1": n(ks[3], (DEPTH, ATTN_HEAD_DIM), 0.1),
        "lambda_k1": n(ks[4], (DEPTH, ATTN_HEAD_DIM), 0.1),
        "lambda_q2": n(ks[5], (DEPTH, ATTN_HEAD_DIM), 0.1),
        "lambda_k2": n(ks[6], (DEPTH, ATTN_HEAD_DIM), 0.1),
        "subln_g": 1.0 + n(ks[7], (DEPTH, ATTN_V_DIM), 0.1),
        "beta_attn": 1.0 + n(ks[8], (DEPTH, D_ATTN), 0.1),
        "gmlp_ln_g": 1.0 + n(ks[9], (DEPTH, D_GMLP), 0.1),
        "gmlp_ln_b": n(ks[10], (DEPTH, D_GMLP), 0.02),
        "spatial_w": n(ks[11], (DEPTH, GMLP_HEADS, CHUNK, CHUNK), CHUNK ** -0.5),
        "spatial_b": 1.0 + n(ks[12], (DEPTH, GMLP_HEADS, CHUNK), 0.1),
        "beta_gmlp": 1.0 + n(ks[13], (DEPTH, D_GMLP), 0.1),
        "rel_bias": n(ks[14], (REL_BUCKETS, ATTN_HEADS), 0.5),
        "ln1_g": 1.0 + n(ks[15], (DEPTH, D_MODEL), 0.1),
        "ln1_b": n(ks[16], (DEPTH, D_MODEL), 0.02),
        "w_group": n(ks[17], (DEPTH, D_MODEL, N_GROUPS), D_MODEL ** -0.5),
        "b_group": n(ks[18], (DEPTH, N_GROUPS), 0.01),
        "w_expert": n(ks[19], (DEPTH, D_MODEL, N_GROUPS, EXPERTS_PER_GROUP), D_MODEL ** -0.5),
        "b_expert": n(ks[20], (DEPTH, N_GROUPS, EXPERTS_PER_GROUP), 0.01),
        "w_gate": n(ks[21], (DEPTH, N_EXPERTS, D_MODEL, D_FF_EXPERT), D_MODEL ** -0.5),
        "w_up": n(ks[22], (DEPTH, N_EXPERTS, D_MODEL, D_FF_EXPERT), D_MODEL ** -0.5),
        "w_down": n(ks[23], (DEPTH, N_EXPERTS, D_FF_EXPERT, D_MODEL), D_FF_EXPERT ** -0.5 * DN_BETA),
        "ln2_g": 1.0 + n(ks[24], (DEPTH, D_MODEL), 0.1),
        "ln2_b": n(ks[25], (DEPTH, D_MODEL), 0.02),
    }


def reference(x, w_in, w_out, lambda_q1, lambda_k1, lambda_q2, lambda_k2, subln_g, beta_attn,
              gmlp_ln_g, gmlp_ln_b, spatial_w, spatial_b, beta_gmlp, rel_bias, ln1_g, ln1_b,
              w_group, b_group, w_expert, b_expert, w_gate, w_up, w_down, ln2_g, ln2_b):
    B, S, _ = x.shape
    for l in range(DEPTH):
        lambda_init = 0.8 - 0.6 * math.exp(-0.3 * l)
        proj = x @ w_in[l]
        q, k, v, u, g = jnp.split(proj, [D_ATTN, 2 * D_ATTN, 3 * D_ATTN, 3 * D_ATTN + D_GMLP], axis=-1)
        q = q.reshape(B, S, ATTN_HEADS, 2, ATTN_HEAD_DIM).transpose(0, 2, 3, 1, 4)
        k = k.reshape(B, S, ATTN_HEADS, 2, ATTN_HEAD_DIM).transpose(0, 2, 3, 1, 4)
        v = v.reshape(B, S, ATTN_HEADS, ATTN_V_DIM).transpose(0, 2, 1, 3)
        lam = (jnp.exp(jnp.sum(lambda_q1[l].astype(jnp.float32) * lambda_k1[l].astype(jnp.float32)))
               - jnp.exp(jnp.sum(lambda_q2[l].astype(jnp.float32) * lambda_k2[l].astype(jnp.float32)))
               + lambda_init)
        attn = diff_attention(q, k, v, lam, lambda_init, subln_g[l], rel_bias) * beta_attn[l]
        gm = rms_norm(chunked_spatial_gating(u, g, gmlp_ln_g[l], gmlp_ln_b[l], spatial_w[l], spatial_b[l]),
                      beta_gmlp[l])
        mix = jnp.concatenate([attn, gm], axis=-1) @ w_out[l]
        x = layer_norm(DN_ALPHA * x + mix, ln1_g[l], ln1_b[l])
        moe = hierarchical_moe(x, w_group[l], b_group[l], w_expert[l], b_expert[l],
                               w_gate[l], w_up[l], w_down[l])
        x = layer_norm(DN_ALPHA * x + moe, ln2_g[l], ln2_b[l])
    return x
```

```cpp
#include <hip/hip_runtime.h>
#include <cstdio>
#include <cstdint>
namespace pg8 {
#define PG8_LAS __attribute__((address_space(3)))
typedef unsigned short bf16_t;
typedef short bf16x8 __attribute__((ext_vector_type(8)));
typedef float f32x4 __attribute__((ext_vector_type(4)));
typedef unsigned u32x4 __attribute__((ext_vector_type(4)));
constexpr int BM = 256, BK = 64, HALF = 128, HTB = HALF * BK * 2  , STAGE_BYTES = 8 * HTB, NXCD = 8, WGM = 8;

__host__ __device__ __forceinline__ int lds_byte(int r, int c) { const int st = (r >> 4) * 2 + (c >> 5), rr = r & 15, cc = c & 31, ob = rr * 64 + cc * 2; return st * 1024 + (ob ^ (((ob >> 9) & 1) << 5)); }
__host__ __device__ __forceinline__ void stage_rc(int b, int& R, int& C) { const int st = b / 1024, sb = b % 1024, swz = sb ^ (((sb >> 9) & 1) << 5); R = (st >> 1) * 16 + swz / 64; C = (st & 1) * 32 + (swz % 64) / 2; }
__host__ __device__ __forceinline__ int perm32(int rho) { const int n = rho >> 4, i = rho & 15; return 8 * (i >> 2) + 4 * n + (i & 3); }

struct Unit { int pm, pn; };
struct Gemm { const bf16_t* A; const bf16_t* Bt; int M, N, K; };

struct StaticOrder {
    int nM, nN, nwg, G, c;
    __host__ __device__ void init(int M, int N, int G_, int c_) { nM = M / BM; nN = N / BM; nwg = nM * nN; G = G_; c = c_; }
    __host__ __device__ bool next(int i, Unit& u) const {
        const long L = (long)i * G + c; if (L >= nwg) return false;
        int wgid = (int)L; { const int q = nwg / NXCD, r = nwg % NXCD, xcd = wgid % NXCD, off = wgid / NXCD; wgid = (xcd < r ? xcd * (q + 1) : r * (q + 1) + (xcd - r) * q) + off; }
        const int nig = WGM * nN, gid = wgid / nig, fm = gid * WGM, gsz = (nM - fm) < WGM ? (nM - fm) : WGM;
        u.pm = fm + ((wgid % nig) % gsz); u.pn = (wgid % nig) / gsz; return true;
    }
    __device__ __forceinline__ void a_ready(const Unit&) const {}
    __device__ __forceinline__ void done(const Unit&) const {}
};
__device__ __forceinline__ unsigned cvt_pk_bf16(float lo, float hi) { unsigned r; asm volatile("v_cvt_pk_bf16_f32 %0, %1, %2" : "=v"(r) : "v"(lo), "v"(hi)); return r; }
typedef float f32x2 __attribute__((ext_vector_type(2)));
__device__ __forceinline__ f32x2 gelu_pk(f32x2 v) {
    const f32x2 av = __builtin_elementwise_abs(v), d = av * 0.2316418882f + 1.0f;
    f32x2 t; t.x = __builtin_amdgcn_rcpf(d.x); t.y = __builtin_amdgcn_rcpf(d.y);
    f32x2 q = t * 0.5307027145f + (-0.7265760135f); q = q * t + 0.7107068705f; q = q * t + (-0.142248368f); q = q * t + 0.127414796f; q = q * t;
    const f32x2 s = (v * v) * (-0.72134752044f);
    f32x2 e; e.x = __builtin_amdgcn_exp2f(s.x); e.y = __builtin_amdgcn_exp2f(s.y);
    const f32x2 m = v * (q * e), r = v - m;
    f32x2 o; o.x = v.x < 0.f ? m.x : r.x; o.y = v.y < 0.f ? m.y : r.y; return o;
}
template <class Epi, class Sched, bool ALIGN_EPI = false, bool SP2 = false>
__device__ __forceinline__ void gemm_phase(PG8_LAS unsigned char* lds, const Gemm g, const Sched& S, const Epi& E, int wid) {
    int lane; asm volatile("v_mbcnt_lo_u32_b32 %0, -1, 0\n\tv_mbcnt_hi_u32_b32 %0, -1, %0" : "=v"(lane));
    const int tid = wid * 64 + lane, wr = wid >> 2, wc = wid & 3, fr = lane & 15, fq = lane >> 4;
    const int K = g.K, nt = K / BK;
    unsigned voffA[2], voffB[2];
#pragma unroll
    for (int i = 0; i < 2; ++i) { int R, C; stage_rc(tid * 16 + i * 8192, R, C); const int Rb = Epi::PERM ? ((R & ~31) + perm32(R & 31)) : R;
        voffA[i] = (unsigned)(R * K + C) * 2u; voffB[i] = (unsigned)(Rb * K + C) * 2u; }
    const size_t kstep = (size_t)(BK * 2);
    const size_t hstep = (size_t)HALF * K * 2;
    const size_t tstep = 2 * hstep;
    const unsigned ldsw = (unsigned)wid * 1024u;
    const int aoff = lds_byte(wr * 64 + fr, fq * 8), boff = lds_byte(wc * 32 + fr, fq * 8);
#define PG8_SA(b, h) (((b) * 2 + (h)) * HTB)
#define PG8_SB(b, h) ((4 + (b) * 2 + (h)) * HTB)
#define PG8_STAGE(bufoff, gbase, voff) do { _Pragma("unroll") for (int _i = 0; _i < 2; ++_i) \
        __builtin_amdgcn_global_load_lds((const unsigned*)((const char*)(gbase) + (voff)[_i]), (PG8_LAS unsigned*)(lds + (bufoff) + ldsw + _i * 8192), 16, 0, 0); } while (0)
#define PG8_LDA(dst, b, h) do { _Pragma("unroll") for (int m = 0; m < 4; ++m) _Pragma("unroll") for (int k = 0; k < 2; ++k) dst[m][k] = *(const PG8_LAS bf16x8*)(lds + PG8_SA(b, h) + aoff + m * 2048 + k * 1024); } while (0)
#define PG8_LDB(dst, b, h) do { _Pragma("unroll") for (int n = 0; n < 2; ++n) _Pragma("unroll") for (int k = 0; k < 2; ++k) dst[n][k] = *(const PG8_LAS bf16x8*)(lds + PG8_SB(b, h) + boff + n * 2048 + k * 1024); } while (0)
#define PG8_MMA(ai, bj, At, Bt) do { __builtin_amdgcn_s_setprio(1); _Pragma("unroll") for (int m = 0; m < 4; ++m) _Pragma("unroll") for (int n = 0; n < 2; ++n) _Pragma("unroll") for (int k = 0; k < 2; ++k) \
        acc[ai][bj][m][n] = __builtin_amdgcn_mfma_f32_16x16x32_bf16(Bt[n][k], At[m][k], acc[ai][bj][m][n], 0, 0, 0); __builtin_amdgcn_s_setprio(0); } while (0)
#define PG8_WAIT_V(n) asm volatile("s_waitcnt vmcnt(" #n ")" ::: "memory")
#define PG8_WAIT_L(n) asm volatile("s_waitcnt lgkmcnt(" #n ")" ::: "memory")
#define PG8_BAR __builtin_amdgcn_s_barrier()
#define PG8_SCHED __builtin_amdgcn_sched_barrier(0)
    Unit cur, nxt; int ui = 0;
    if (!S.next(0, cur)) return;
    f32x4 acc[2][2][4][2];
#pragma unroll
    for (int a = 0; a < 2; ++a)
#pragma unroll
        for (int b = 0; b < 2; ++b)
#pragma unroll
            for (int m = 0; m < 4; ++m)
#pragma unroll
                for (int n = 0; n < 2; ++n) acc[a][b][m][n] = (f32x4){0.f, 0.f, 0.f, 0.f};
    bf16x8 At[4][2], B0[2][2], B1[2][2];
    const char* cA = (const char*)g.A + (size_t)cur.pm * tstep; const char* cB = (const char*)g.Bt + (size_t)cur.pn * tstep;
    S.a_ready(cur);
    if constexpr (SP2) {
        PG8_STAGE(PG8_SB(0, 0), cB, voffB); PG8_STAGE(PG8_SB(0, 1), cB + hstep, voffB); PG8_STAGE(PG8_SA(0, 0), cA, voffA); PG8_STAGE(PG8_SA(0, 1), cA + hstep, voffA);
        if (wr == 1) PG8_BAR;
        PG8_WAIT_V(2); PG8_BAR;
        PG8_STAGE(PG8_SB(1, 0), cB + kstep, voffB); PG8_STAGE(PG8_SA(1, 0), cA + kstep, voffA); PG8_STAGE(PG8_SB(1, 1), cB + hstep + kstep, voffB);
        PG8_WAIT_V(6); PG8_BAR;
    } else {
        PG8_STAGE(PG8_SB(0, 0), cB, voffB); PG8_STAGE(PG8_SA(0, 0), cA, voffA); PG8_STAGE(PG8_SB(0, 1), cB + hstep, voffB); PG8_STAGE(PG8_SA(0, 1), cA + hstep, voffA);
        if (wr == 1) PG8_BAR;
        PG8_WAIT_V(4); PG8_BAR;
        PG8_STAGE(PG8_SB(1, 0), cB + kstep, voffB); PG8_STAGE(PG8_SA(1, 0), cA + kstep, voffA); PG8_STAGE(PG8_SB(1, 1), cB + hstep + kstep, voffB);
        PG8_WAIT_V(6); PG8_BAR;
    }
    for (;;) {
        const bool has_next = S.next(ui + 1, nxt);
        const char* nA = has_next ? (const char*)g.A + (size_t)nxt.pm * tstep : cA; const char* nB = has_next ? (const char*)g.Bt + (size_t)nxt.pn * tstep : cB;
        for (int t = 0; t < nt; t += 2) {
            const bool last = (t == nt - 2);
            const char* a1 = cA + (size_t)(t + 1) * kstep;
            const char* a2 = last ? nA : cA + (size_t)(t + 2) * kstep; const char* b2 = last ? nB : cB + (size_t)(t + 2) * kstep;
            const char* a3 = a2 + kstep; const char* b3 = b2 + kstep;
            if (last && has_next) S.a_ready(nxt);
            if constexpr (Epi::MIDK) { if (t == nt / 2) E.midk(acc, cur, wr, wc, fr, fq); }
            if constexpr (SP2) {
            PG8_LDB(B0, 0, 0); PG8_LDB(B1, 0, 1); PG8_SCHED; PG8_LDA(At, 0, 0); PG8_STAGE(PG8_SA(1, 1), a1 + hstep, voffA);
            PG8_WAIT_V(8); PG8_WAIT_L(0); PG8_BAR; PG8_MMA(0, 0, At, B0); PG8_MMA(0, 1, At, B1); PG8_BAR; PG8_SCHED;
            PG8_LDA(At, 0, 1); PG8_STAGE(PG8_SB(0, 0), b2, voffB); PG8_STAGE(PG8_SB(0, 1), b2 + hstep, voffB); PG8_STAGE(PG8_SA(0, 0), a2, voffA);
            PG8_WAIT_V(8); PG8_WAIT_L(0); PG8_BAR; PG8_MMA(1, 0, At, B0); PG8_MMA(1, 1, At, B1); PG8_BAR; PG8_SCHED;
            PG8_LDB(B0, 1, 0); PG8_LDB(B1, 1, 1); PG8_SCHED; PG8_LDA(At, 1, 0); PG8_STAGE(PG8_SA(0, 1), a2 + hstep, voffA);
            PG8_WAIT_V(8); PG8_WAIT_L(0); PG8_BAR; PG8_MMA(0, 0, At, B0); PG8_MMA(0, 1, At, B1); PG8_BAR; PG8_SCHED;
            PG8_LDA(At, 1, 1); PG8_STAGE(PG8_SB(1, 0), b3, voffB); PG8_STAGE(PG8_SB(1, 1), b3 + hstep, voffB); PG8_STAGE(PG8_SA(1, 0), a3, voffA);
            PG8_WAIT_V(8); PG8_WAIT_L(0); PG8_BAR; PG8_MMA(1, 0, At, B0); PG8_MMA(1, 1, At, B1); PG8_BAR; PG8_SCHED;
            } else {
            PG8_LDB(B0, 0, 0); PG8_SCHED; PG8_LDA(At, 0, 0); PG8_STAGE(PG8_SA(1, 1), a1 + hstep, voffA);
            PG8_WAIT_L(8); PG8_BAR; PG8_WAIT_L(0); PG8_MMA(0, 0, At, B0); PG8_BAR; PG8_SCHED;
            PG8_LDB(B1, 0, 1); PG8_STAGE(PG8_SB(0, 0), b2, voffB);
            PG8_BAR; PG8_WAIT_L(0); PG8_MMA(0, 1, At, B1); PG8_BAR;
            PG8_LDA(At, 0, 1); PG8_STAGE(PG8_SA(0, 0), a2, voffA);
            PG8_BAR; PG8_WAIT_L(0); PG8_MMA(1, 0, At, B0); PG8_BAR; PG8_SCHED;
            PG8_STAGE(PG8_SB(0, 1), b2 + hstep, voffB);
            PG8_WAIT_V(6); PG8_BAR; PG8_MMA(1, 1, At, B1); PG8_BAR;
            PG8_LDB(B0, 1, 0); PG8_SCHED; PG8_LDA(At, 1, 0); PG8_STAGE(PG8_SA(0, 1), a2 + hstep, voffA);
            PG8_WAIT_L(8); PG8_BAR; PG8_WAIT_L(0); PG8_MMA(0, 0, At, B0); PG8_BAR; PG8_SCHED;
            PG8_LDB(B1, 1, 1); PG8_STAGE(PG8_SB(1, 0), b3, voffB);
            PG8_BAR; PG8_WAIT_L(0); PG8_MMA(0, 1, At, B1); PG8_BAR;
            PG8_LDA(At, 1, 1); PG8_STAGE(PG8_SA(1, 0), a3, voffA);
            PG8_BAR; PG8_WAIT_L(0); PG8_MMA(1, 0, At, B0); PG8_BAR; PG8_SCHED;
            PG8_STAGE(PG8_SB(1, 1), b3 + hstep, voffB);
            PG8_WAIT_V(6); PG8_BAR; PG8_MMA(1, 1, At, B1); PG8_BAR;
            }
        }
        if constexpr (ALIGN_EPI) { if (wr == 0) PG8_BAR; }
        if constexpr (!Epi::AFTER_DRAIN) { E(acc, cur, wr, wc, fr, fq); S.done(cur); }
        if (!has_next) break;
#pragma unroll
        for (int a = 0; a < 2; ++a)
#pragma unroll
            for (int b = 0; b < 2; ++b)
#pragma unroll
                for (int m = 0; m < 4; ++m)
#pragma unroll
                    for (int n = 0; n < 2; ++n) acc[a][b][m][n] = (f32x4){0.f, 0.f, 0.f, 0.f};
        cur = nxt; cA = nA; cB = nB; ++ui;
        if constexpr (ALIGN_EPI) { if (wr == 1) PG8_BAR; }
    }
    PG8_WAIT_V(0);
    if constexpr (!ALIGN_EPI) { if (wr == 0) PG8_BAR; }
    PG8_BAR;
    if constexpr (Epi::AFTER_DRAIN) { E.fused(acc, cur, wr, wc, fr, fq, lds, wid, lane); S.done(cur); }
#undef PG8_SA
#undef PG8_SB
#undef PG8_STAGE
#undef PG8_LDA
#undef PG8_LDB
#undef PG8_MMA
#undef PG8_WAIT_V
#undef PG8_WAIT_L
#undef PG8_BAR
#undef PG8_SCHED
}
}
#define XB_TMO      128
#define XB_XCNT(j)  (256  + 64 * (j))
#define XB_XSUB(j)  (1280 + 64 * (j))
#define XB_XGEN(j)  (2304 + 64 * (j))
#define XB_TOP      3328
#define XB_TOPGEN   3392
#define XCD_BAR_WORDS 3456
#define XB_SPIN_CAP (1u << 18)
#define LAS __attribute__((address_space(3)))

__device__ __forceinline__ unsigned xb_ld(unsigned* p)              { return __hip_atomic_load(p, __ATOMIC_RELAXED, __HIP_MEMORY_SCOPE_AGENT); }
__device__ __forceinline__ unsigned xb_add(unsigned* p, unsigned v) { return __hip_atomic_fetch_add(p, v, __ATOMIC_RELAXED, __HIP_MEMORY_SCOPE_AGENT); }
__device__ __forceinline__ unsigned xb_xcc_id() { return (unsigned)__builtin_amdgcn_s_getreg((3 << 11) | 20) & 0xFu; }
#define XB_SPIN(cond, bar) do { unsigned _sp = 0; while (cond) { __builtin_amdgcn_s_sleep(1); \
    if ((++_sp & 255u) == 0u) { if (xb_ld(&(bar)[XB_TMO])) break; if (_sp > XB_SPIN_CAP) { atomicAdd(&(bar)[XB_TMO], 1u); break; } } } } while (0)

__device__ __forceinline__ bool xb_lane0() { int l; asm volatile("v_mbcnt_lo_u32_b32 %0, -1, 0\n\tv_mbcnt_hi_u32_b32 %0, -1, %0" : "=v"(l)); return l == 0; }
struct XcdBarrier {
    unsigned w;
    unsigned* bar; unsigned x;
    volatile LAS unsigned* st;
};

__device__ __forceinline__ XcdBarrier xcd_barrier_post(unsigned* bar, volatile LAS unsigned* st) {
    XcdBarrier b; b.bar = bar; b.x = xb_xcc_id(); b.st = st; b.w = (unsigned)__builtin_amdgcn_readfirstlane(threadIdx.x >> 6);
    if (b.w == 0u && xb_lane0()) (void)xb_add(&bar[XB_XCNT(b.x)], 1u);
    return b;
}
__device__ __forceinline__ void xcd_barrier_complete(unsigned* bar, unsigned x, unsigned& nloc, unsigned& nx) {
    const unsigned G = gridDim.x * gridDim.y * gridDim.z;
    unsigned sum, cnt, mine, sp = 0u;
    for (;;) {
        sum = 0u; cnt = 0u; mine = 0u;
#pragma unroll
        for (unsigned j = 0; j < 16; ++j) { const unsigned c = xb_ld(&bar[XB_XCNT(j)]); sum += c; cnt += (c > 0u) ? 1u : 0u; mine = (j == x) ? c : mine; }
        if (sum == G) break;
        __builtin_amdgcn_s_sleep(1);
        if ((++sp & 255u) == 0u) { if (xb_ld(&bar[XB_TMO])) break; if (sp > XB_SPIN_CAP) { atomicAdd(&bar[XB_TMO], 1u); break; } }
    }
    nloc = mine > 0u ? mine : 1u; nx = cnt > 0u ? cnt : 1u;
}

__device__ __forceinline__ void xcd_barrier(const XcdBarrier& b) {
    asm volatile("s_waitcnt vmcnt(0)" ::: "memory");
    __syncthreads();
    if (b.w == 0u && xb_lane0()) {
        unsigned* bar = b.bar;
        __builtin_amdgcn_s_waitcnt(0);
        unsigned nloc = b.st[0], nx = b.st[1];
        if (nloc == 0u) { xcd_barrier_complete(bar, b.x, nloc, nx); b.st[0] = nloc; b.st[1] = nx; }
        const unsigned old = xb_add(&bar[XB_XSUB(b.x)], 1u);
        const unsigned gen = old / nloc;
        if (old + 1u == (gen + 1u) * nloc) {
            __builtin_amdgcn_fence(__ATOMIC_RELEASE, "agent");
            asm volatile("s_waitcnt vmcnt(0)" ::: "memory");
            const unsigned og = xb_add(&bar[XB_TOP], 1u);
            const unsigned tg = og / nx;
            if (og + 1u == (tg + 1u) * nx) xb_add(&bar[XB_TOPGEN], 1u);
            else XB_SPIN(xb_ld(&bar[XB_TOPGEN]) == tg, bar);
            __builtin_amdgcn_fence(__ATOMIC_ACQUIRE, "agent");
            xb_add(&bar[XB_XGEN(b.x)], 1u);
            asm volatile("s_waitcnt vmcnt(0)" ::: "memory");
        } else {
            XB_SPIN(xb_ld(&bar[XB_XGEN(b.x)]) == gen, bar);
            __builtin_amdgcn_fence(__ATOMIC_ACQUIRE, "agent");
            asm volatile("s_waitcnt vmcnt(0)" ::: "memory");
        }
    }
    __syncthreads();
}
namespace mk {
using pg8::bf16x8; using pg8::f32x4; using pg8::u32x4; using pg8::bf16_t; using pg8::f32x2; using pg8::gelu_pk;
typedef float f32x16 __attribute__((ext_vector_type(16)));
typedef float f32x8 __attribute__((ext_vector_type(8)));
typedef short s16x4 __attribute__((ext_vector_type(4)));
typedef unsigned u32x2 __attribute__((ext_vector_type(2)));
typedef __bf16 nbf16x8 __attribute__((ext_vector_type(8)));
typedef __bf16 nbf16x4 __attribute__((ext_vector_type(4)));
typedef int i32x4 __attribute__((ext_vector_type(4)));

constexpr int NTOK = 8192, DM = 4096, SEQ = 2048, DIN = 10240, SW = 2048;
constexpr int NEXP = 64, DFF = 512;
constexpr float LN_EPS = 1e-5f;
constexpr float ALPHA = 1.189207115002721f;
constexpr float LOG2E = 1.4426950408889634f;
constexpr float QSCALE = 0.08838834764831845f * 1.4426950408889634f;
constexpr float NEG_BIG = -1e30f;
constexpr float LAMBDA_INIT = 0.2f;

constexpr size_t MiB = 1u << 20;
constexpr size_t WS_CTL = 0, CTL_ZERO_BYTES = 1 * MiB;
constexpr size_t WS_XB = 2 * MiB;
constexpr size_t WS_WINT = WS_XB + 64 * MiB;
constexpr size_t WS_WOUTT = WS_WINT + 80 * MiB;
constexpr size_t WS_WRT = WS_WOUTT + 32 * MiB;
constexpr size_t WS_QKVUG = WS_WRT + 2 * MiB;
constexpr size_t WS_GSTAT = WS_QKVUG + 160 * MiB;
constexpr size_t WS_AO = WS_GSTAT + 2 * MiB;
constexpr size_t WS_Y = WS_AO + 64 * MiB;
constexpr size_t WS_X1B = WS_Y + 128 * MiB;
constexpr size_t WS_ROUTE = WS_X1B + 64 * MiB;
constexpr size_t WS_TOKL = WS_ROUTE + 1 * MiB;
constexpr size_t WS_WL = WS_TOKL + 2 * MiB;
constexpr size_t WS_H = WS_WL + 2 * MiB;
constexpr size_t WS_YS = WS_H + 16 * MiB;
constexpr float YS_SCALE = 64.0f;
constexpr size_t WS_YSTAT = WS_YS + 128 * MiB;
constexpr size_t WS_GPART = WS_YSTAT + 4 * MiB;
constexpr size_t WS_END = WS_GPART + 1 * MiB;
constexpr int CW_CNT = 4096;
constexpr int CW_BAR = 8192;
constexpr int LDS_BYTES = 163840;
constexpr int MISC_OFF = LDS_BYTES - 256;

__device__ __forceinline__ float bf2f(unsigned short b) { return __uint_as_float(((unsigned)b) << 16); }
__device__ __forceinline__ unsigned f2bf(float f) { unsigned u = __float_as_uint(f); return (u + 0x7fffu + ((u >> 16) & 1u)) >> 16; }
__device__ __forceinline__ unsigned pk2(float lo, float hi) { return f2bf(lo) | (f2bf(hi) << 16); }
__device__ __forceinline__ bf16x8 cvt8(f32x8 v) { return __builtin_bit_cast(bf16x8, __builtin_convertvector(v, nbf16x8)); }
__device__ __forceinline__ s16x4 cvt4(f32x4 v) { return __builtin_bit_cast(s16x4, __builtin_convertvector(v, nbf16x4)); }
__device__ __forceinline__ float wave_sum(float v) {
#pragma unroll
    for (int o = 1; o < 64; o <<= 1) v += __shfl_xor(v, o);
    return v;
}
#define MFMA32(a, b, c) __builtin_amdgcn_mfma_f32_32x32x16_bf16((a), (b), (c), 0, 0, 0)
#define MFMA16(a, b, c) __builtin_amdgcn_mfma_f32_16x16x32_bf16((a), (b), (c), 0, 0, 0)

template <bool SCALE>
__device__ __forceinline__ void p0_transpose_item(const float* W, int K, int N, bf16_t* WT, LAS float* scr, int item, int lane,
                                                  const float* subln_g, const float* beta_attn, const float* beta_gmlp) {
    const int nblk = N / 64, kb = item / nblk, nb = item % nblk, k0 = 64 * kb, n0 = 64 * nb;
#pragma unroll
    for (int hb = 0; hb < 2; ++hb) {
        float v[32];
#pragma unroll
        for (int i = 0; i < 32; ++i) v[i] = __builtin_nontemporal_load(W + (size_t)(k0 + 32 * hb + i) * N + n0 + lane);
#pragma unroll
        for (int i = 0; i < 32; ++i) {
            const int kk = 32 * hb + i; float t = v[i];
            if (SCALE) { const int k = k0 + kk; const float sc = (k < SW) ? subln_g[k & 255] * (1.0f - LAMBDA_INIT) * beta_attn[k] : beta_gmlp[k - SW]; t *= sc; }
            scr[kk * 65 + lane] = t; }
    }
    asm volatile("s_waitcnt lgkmcnt(0)" ::: "memory");
    const int c = lane & 7;
#pragma unroll
    for (int j = 0; j < 8; ++j) { const int n = (lane >> 3) + 8 * j; const LAS float* s = scr + (8 * c) * 65 + n;
        u32x4 o; o.x = pk2(s[0 * 65], s[1 * 65]); o.y = pk2(s[2 * 65], s[3 * 65]); o.z = pk2(s[4 * 65], s[5 * 65]); o.w = pk2(s[6 * 65], s[7 * 65]);
        *(u32x4*)(WT + (size_t)(n0 + n) * K + (SCALE ? ((k0 + SW) & (DM - 1)) : k0) + 8 * c) = o; }
    asm volatile("s_waitcnt lgkmcnt(0)" ::: "memory");
}

__device__ __forceinline__ void p0_prologue(LAS unsigned char* lds, const float* const* in, unsigned char* ws, int vcu, int G, int tid, int wid, int lane) {
    const float* x = in[0]; const float* w_in = in[1]; const float* w_out = in[2];
    bf16_t* XB = (bf16_t*)(ws + WS_XB); bf16_t* WINT = (bf16_t*)(ws + WS_WINT); bf16_t* WOUTT = (bf16_t*)(ws + WS_WOUTT); bf16_t* WRT = (bf16_t*)(ws + WS_WRT);
    { const size_t nch = (size_t)NTOK * DM / 8, nthr = (size_t)G * 512; const f32x4* xi = (const f32x4*)x; u32x4* xo = (u32x4*)XB;
      for (size_t i = (size_t)vcu * 512 + tid; i < nch; i += 4 * nthr) {
          f32x4 a[4], b[4];
#pragma unroll
          for (int q = 0; q < 4; ++q) { const size_t c = (i + q * nthr) < nch ? (i + q * nthr) : i; a[q] = __builtin_nontemporal_load(xi + 2 * c); b[q] = __builtin_nontemporal_load(xi + 2 * c + 1); }
#pragma unroll
          for (int q = 0; q < 4; ++q) { f32x8 v = {a[q][0], a[q][1], a[q][2], a[q][3], b[q][0], b[q][1], b[q][2], b[q][3]}; if (i + q * nthr < nch) xo[i + q * nthr] = __builtin_bit_cast(u32x4, cvt8(v)); } } }
    LAS float* scr = (LAS float*)(lds + wid * 16896);
    const int gw = vcu * 8 + wid, NGW = G * 8;
    constexpr int I_IN = (DM / 64) * (DIN / 64), I_OUT = (DM / 64) * (DM / 64);
    for (int it = gw; it < I_IN + I_OUT; it += NGW) {
        if (it < I_IN) p0_transpose_item<false>(w_in, DM, DIN, WINT, scr, it, lane, nullptr, nullptr, nullptr);
        else p0_transpose_item<true>(w_out, DM, DM, WOUTT, scr, it - I_IN, lane, in[7], in[8], in[13]);
    }
    { const float* wg = in[17]; const float* we = in[19];
      for (int i = vcu * 512 + tid; i < 80 * DM; i += G * 512) { const int j = i / DM, c = i % DM;
          const float v = j < 8 ? wg[c * 8 + j] : (j < 72 ? we[c * 64 + (j - 8)] : 0.f);
          const unsigned hi = f2bf(v); const float r = v - __uint_as_float(hi << 16);
          WRT[i] = (bf16_t)hi; WRT[80 * DM + i] = (bf16_t)f2bf(r); } }
}

struct EpiProj {
    static constexpr bool PERM = true, AFTER_DRAIN = false, MIDK = false;
    bf16_t* base; float* gstat;
    __device__ __forceinline__ void operator()(const f32x4 (&acc)[2][2][4][2], const pg8::Unit& u, int wr, int wc, int fr, int fq) const {
        const int sect = u.pn >> 3, colt = (u.pn & 7) * 256;
        bf16_t* O = base + (size_t)sect * ((size_t)NTOK * SW);
        const int row0 = u.pm * 256 + wr * 64 + fr, col0 = colt + wc * 32 + 8 * fq;
#pragma unroll
        for (int ai = 0; ai < 2; ++ai)
#pragma unroll
            for (int m = 0; m < 4; ++m) {
                const int row = row0 + ai * 128 + m * 16;
                bf16_t* rowp = O + (size_t)row * SW + col0; float s1 = 0.f, s2 = 0.f;
#pragma unroll
                for (int bj = 0; bj < 2; ++bj) {
                    f32x4 v0 = acc[ai][bj][m][0], v1 = acc[ai][bj][m][1];
                    if (sect == 0) { v0 *= QSCALE; v1 *= QSCALE; }
                    if (sect >= 3) { f32x2 a = gelu_pk((f32x2){v0[0], v0[1]}), b = gelu_pk((f32x2){v0[2], v0[3]}), c = gelu_pk((f32x2){v1[0], v1[1]}), d = gelu_pk((f32x2){v1[2], v1[3]});
                        v0 = (f32x4){a.x, a.y, b.x, b.y}; v1 = (f32x4){c.x, c.y, d.x, d.y}; }
                    if (sect == 4) { s1 += (v0[0] + v0[1]) + (v0[2] + v0[3]) + (v1[0] + v1[1]) + (v1[2] + v1[3]);
                        s2 += (v0[0] * v0[0] + v0[1] * v0[1]) + (v0[2] * v0[2] + v0[3] * v0[3]) + (v1[0] * v1[0] + v1[1] * v1[1]) + (v1[2] * v1[2] + v1[3] * v1[3]); }
                    f32x8 v8 = {v0[0], v0[1], v0[2], v0[3], v1[0], v1[1], v1[2], v1[3]};
                    *(u32x4*)(rowp + bj * 128) = __builtin_bit_cast(u32x4, cvt8(v8));
                }
                if (sect == 4) { s1 += __shfl_xor(s1, 16); s1 += __shfl_xor(s1, 32); s2 += __shfl_xor(s2, 16); s2 += __shfl_xor(s2, 32);
                    if (fq == 0) *(f32x2*)(gstat + ((size_t)row * 32 + (u.pn & 7) * 4 + wc) * 2) = (f32x2){s1, s2}; }
            }
    }
};

struct EpiY {
    static constexpr bool PERM = true, AFTER_DRAIN = false, MIDK = true;
    const bf16_t* xb; bf16_t* Y; float* ystat; const float* gpart;
    __device__ __forceinline__ void midk(f32x4 (&acc)[2][2][4][2], const pg8::Unit& u, int wr, int wc, int fr, int fq) const {
        int fro = fr; asm volatile("" : "+v"(fro));
        const float* gp0 = gpart + (size_t)(u.pm * 256 + wr * 64 + fro) * 8;
#pragma unroll
        for (int ai = 0; ai < 2; ++ai)
#pragma unroll
            for (int m = 0; m < 4; ++m) { const float* gp = gp0 + (ai * 128 + m * 16) * 8; const f32x4 a = *(const f32x4*)gp, b = *(const f32x4*)(gp + 4);
                const float rs = __builtin_amdgcn_rsqf(((a[0] + a[1]) + (a[2] + a[3]) + (b[0] + b[1]) + (b[2] + b[3])) * (1.0f / SW) + LN_EPS);
#pragma unroll
                for (int bj = 0; bj < 2; ++bj)
#pragma unroll
                    for (int n = 0; n < 2; ++n) acc[ai][bj][m][n] *= rs;
                asm volatile("" ::: "memory"); }
    }
    __device__ __forceinline__ void operator()(const f32x4 (&acc)[2][2][4][2], const pg8::Unit& u, int wr, int wc, int fr, int fq) const {
        const int row0 = u.pm * 256 + wr * 64 + fr, col0 = u.pn * 256 + wc * 32 + 8 * fq;
#pragma unroll
        for (int ai = 0; ai < 2; ++ai)
#pragma unroll
            for (int m = 0; m < 4; ++m) { const int row = row0 + ai * 128 + m * 16; const size_t off = (size_t)row * DM + col0; float s1 = 0.f, s2 = 0.f;
#pragma unroll
                for (int bj = 0; bj < 2; ++bj) { const u32x4 xr = *(const u32x4*)(xb + off + bj * 128);
                    f32x8 y;
                    y[0] = ALPHA * __uint_as_float(xr.x << 16) + acc[ai][bj][m][0][0]; y[1] = ALPHA * __uint_as_float(xr.x & 0xffff0000u) + acc[ai][bj][m][0][1];
                    y[2] = ALPHA * __uint_as_float(xr.y << 16) + acc[ai][bj][m][0][2]; y[3] = ALPHA * __uint_as_float(xr.y & 0xffff0000u) + acc[ai][bj][m][0][3];
                    y[4] = ALPHA * __uint_as_float(xr.z << 16) + acc[ai][bj][m][1][0]; y[5] = ALPHA * __uint_as_float(xr.z & 0xffff0000u) + acc[ai][bj][m][1][1];
                    y[6] = ALPHA * __uint_as_float(xr.w << 16) + acc[ai][bj][m][1][2]; y[7] = ALPHA * __uint_as_float(xr.w & 0xffff0000u) + acc[ai][bj][m][1][3];
                    *(u32x4*)(Y + off + bj * 128) = __builtin_bit_cast(u32x4, cvt8(y));
#pragma unroll
                    for (int j = 0; j < 8; ++j) { s1 += y[j]; s2 += y[j] * y[j]; } }
                s1 += __shfl_xor(s1, 16); s1 += __shfl_xor(s1, 32); s2 += __shfl_xor(s2, 16); s2 += __shfl_xor(s2, 32);
                if (fq == 0) *(f32x2*)(ystat + ((size_t)row * 64 + u.pn * 4 + wc) * 2) = (f32x2){s1, s2};
                asm volatile("" ::: "memory"); }
    }
};
constexpr int AT_STAGE = 65536, AT_K1 = 16384, AT_V = 32768, AT_TAB = 143360  , AT_XSTRIDE = 260;

__device__ __forceinline__ void attn_dma_offsets(unsigned (&ko)[2], unsigned (&vo)[2], int wid, int lane) {
#pragma unroll
    for (int j = 0; j < 2; ++j) { const int i = wid * 2 + j, row = 4 * i + (lane >> 4), gch = (lane & 15) ^ (row & 15);
        ko[j] = (unsigned)((row * SW + 8 * gch) * 2); }
#pragma unroll
    for (int j = 0; j < 2; ++j) { const int i = wid * 4 + j, row = 2 * i + (lane >> 5), gch = (lane & 31) ^ ((row & 3) << 2);
        vo[j] = (unsigned)((row * SW + 8 * gch) * 2); }
}
__device__ __forceinline__ void attn_issue_tile(LAS unsigned char* stage, __amdgpu_buffer_rsrc_t krs, __amdgpu_buffer_rsrc_t vrs, int soff, const unsigned (&ko)[2], const unsigned (&vo)[2], int wid) {
#pragma unroll
    for (int j = 0; j < 2; ++j) {
        __builtin_amdgcn_raw_ptr_buffer_load_lds(krs, (LAS unsigned*)(stage + (wid * 2 + j) * 1024), 16, ko[j], soff, 0, 0);
        __builtin_amdgcn_raw_ptr_buffer_load_lds(krs, (LAS unsigned*)(stage + AT_K1 + (wid * 2 + j) * 1024), 16, ko[j], soff + 256, 0, 0);
    }
#pragma unroll
    for (int j = 0; j < 4; ++j)
        __builtin_amdgcn_raw_ptr_buffer_load_lds(vrs, (LAS unsigned*)(stage + AT_V + (wid * 4 + j) * 1024), 16, vo[j & 1], soff + (j >> 1) * (4 * SW * 2), 0, 0);
}

__device__ __forceinline__ int crow(int reg, int h) { return (reg & 3) + 8 * (reg >> 2) + 4 * h; }
constexpr float AT_THR = 8.0f;

__device__ __forceinline__ void attn_unit(LAS unsigned char* lds, const bf16_t* Qb, const bf16_t* Kb, const bf16_t* Vb, bf16_t* AO,
                                          int b, int h, int qt, float lam, int tid, int wid, int lane_in) {
    int lane = lane_in; asm volatile("" : "+v"(lane));
    const int map = wid >> 2, wq = wid & 3, r = lane & 31, hh = lane >> 5;
    const int hcol = h * 256;
    const size_t seq0 = (size_t)b * SEQ;
    const int qpos = qt * 128 + wq * 32 + r;
    const LAS float* tab = (const LAS float*)(lds + AT_TAB) + 32;
    bf16x8 qf[8];
    { const bf16_t* qp = Qb + (seq0 + qpos) * SW + hcol + map * 128 + 8 * hh;
#pragma unroll
      for (int s = 0; s < 8; ++s) qf[s] = *(const bf16x8*)(qp + 16 * s); }
    const int ntiles = 2 * (qt + 1);
    f32x16 O[8];
#pragma unroll
    for (int c = 0; c < 8; ++c)
#pragma unroll
        for (int i = 0; i < 16; ++i) O[c][i] = 0.f;
    float m_run = NEG_BIG, l_run = 0.f;
    const float farb = tab[255];
    const int kx = r & 15;
    const int q4 = (lane & 15) >> 2, p4 = lane & 3, blk = (lane >> 4) & 1;
    int vb[4];
#pragma unroll
    for (int c1 = 0; c1 < 4; ++c1) vb[c1] = (4 * hh + q4) * 512 + 64 * (c1 ^ q4) + 32 * blk + 16 * (p4 >> 1) + 8 * (p4 & 1);
    unsigned ko[2], vo[2];
    attn_dma_offsets(ko, vo, wid, lane);
    const __amdgpu_buffer_rsrc_t krs = __builtin_amdgcn_make_buffer_rsrc((void*)Kb, 0, NTOK * SW * 2, 0x00020000);
    const __amdgpu_buffer_rsrc_t vrs = __builtin_amdgcn_make_buffer_rsrc((void*)Vb, 0, NTOK * SW * 2, 0x00020000);
    const int soff0 = (int)((seq0 * SW + hcol) * 2);
    constexpr int TILE_BYTES = 64 * SW * 2;

    attn_issue_tile(lds, krs, vrs, soff0, ko, vo, wid);
    asm volatile("s_waitcnt vmcnt(0)" ::: "memory");
    __syncthreads();
#pragma unroll 1
    for (int t = 0; t < ntiles; ++t) {
        LAS unsigned char* stage = lds + (t & 1) * AT_STAGE;
        if (t + 1 < ntiles) attn_issue_tile(lds + ((t + 1) & 1) * AT_STAGE, krs, vrs, soff0 + (t + 1) * TILE_BYTES, ko, vo, wid);
        const int kbase = 64 * t;
        const bool far = (qt * 128 + wq * 32 - (kbase + 63)) >= 128;
#pragma unroll
        for (int tt = 0; tt < 2; ++tt) {
            if (kbase + 32 * tt > qt * 128 + wq * 32 + 31) continue;
            const LAS unsigned char* kt = stage + map * AT_K1 + (32 * tt + r) * 256;
            f32x16 X;
#pragma unroll
            for (int i = 0; i < 16; ++i) X[i] = 0.f;
#pragma unroll
            for (int s = 0; s < 8; ++s) {
                const bf16x8 kf = *(const LAS bf16x8*)(kt + 16 * ((2 * s + hh) ^ kx));
                X = MFMA32(kf, qf[s], X);
            }
            if (far) {
#pragma unroll
                for (int i = 0; i < 16; ++i) X[i] += farb;
            } else {
                const LAS float* tp = tab + (qpos - (kbase + 32 * tt + 4 * hh));
#pragma unroll
                for (int i = 0; i < 16; ++i) X[i] += tp[-((i & 3) + 8 * (i >> 2))];
            }
            float mx = X[0];
#pragma unroll
            for (int i = 1; i < 16; ++i) mx = fmaxf(mx, X[i]);
            mx = fmaxf(mx, __shfl_xor(mx, 32));
            const bool upd = mx > m_run + AT_THR;
            if (__any(upd)) {
                const float mnew = upd ? mx : m_run;
                const float alpha = __builtin_amdgcn_exp2f(m_run - mnew);
                m_run = mnew; l_run *= alpha;
#pragma unroll
                for (int c = 0; c < 8; ++c)
#pragma unroll
                    for (int i = 0; i < 16; ++i) O[c][i] *= alpha;
            }
            float ls = 0.f;
#pragma unroll
            for (int i = 0; i < 16; ++i) { X[i] = __builtin_amdgcn_exp2f(X[i] - m_run); ls += X[i]; }
            l_run += ls;
            bf16x8 pf[2];
#pragma unroll
            for (int s = 0; s < 2; ++s) {
                f32x8 a;
#pragma unroll
                for (int j = 0; j < 8; ++j) a[j] = X[8 * s + j];
                pf[s] = cvt8(a);
            }
            const LAS unsigned char* vt = stage + AT_V + (32 * tt) * 512;
#pragma unroll
            for (int s = 0; s < 2; ++s)
#pragma unroll
                for (int c = 0; c < 8; ++c) {
                    const int rowoff = (16 * s) * 512 + 256 * (c >> 2);
                    const s16x4 lo = __builtin_amdgcn_ds_read_tr16_b64_v4i16((LAS s16x4*)(vt + vb[c & 3] + rowoff));
                    const s16x4 hi = __builtin_amdgcn_ds_read_tr16_b64_v4i16((LAS s16x4*)(vt + vb[c & 3] + rowoff + 8 * 512));
                    const bf16x8 vf = __builtin_shufflevector(lo, hi, 0, 1, 2, 3, 4, 5, 6, 7);
                    O[c] = MFMA32(vf, pf[s], O[c]);
                }
        }
        asm volatile("s_waitcnt vmcnt(0)" ::: "memory");
        __syncthreads();
    }
    const float ltot = l_run + __shfl_xor(l_run, 32);
    const float inv = 1.0f / ltot;
    int lane_e = lane_in; asm volatile("" : "+v"(lane_e));
    const int r_e = lane_e & 31, hh_e = lane_e >> 5;
    LAS float* xb = (LAS float*)lds + (size_t)wq * (32 * AT_XSTRIDE) + r_e * AT_XSTRIDE + 4 * hh_e;
    if (map == 1) {
        const float sc = inv * lam;
#pragma unroll
        for (int c = 0; c < 8; ++c)
#pragma unroll
            for (int g = 0; g < 4; ++g) {
                f32x4 v = {O[c][4 * g] * sc, O[c][4 * g + 1] * sc, O[c][4 * g + 2] * sc, O[c][4 * g + 3] * sc};
                *(LAS f32x4*)(xb + 32 * c + 8 * g) = v;
            }
    }
    __syncthreads();
    if (map == 0) {
        float ss = 0.f;
#pragma unroll
        for (int c = 0; c < 8; ++c)
#pragma unroll
            for (int g = 0; g < 4; ++g) {
                const f32x4 o1 = *(const LAS f32x4*)(xb + 32 * c + 8 * g);
#pragma unroll
                for (int j = 0; j < 4; ++j) { const float d = O[c][4 * g + j] * inv - o1[j]; O[c][4 * g + j] = d; ss += d * d; }
                if (g & 1) asm volatile("" ::: "memory");
            }
        ss += __shfl_xor(ss, 32);
        const float rs = __builtin_amdgcn_rsqf(ss * (1.0f / 256.0f) + LN_EPS);
        bf16_t* op = AO + (seq0 + qt * 128 + wq * 32 + r_e) * DM + SW + hcol + 4 * hh_e;
#pragma unroll
        for (int c = 0; c < 8; ++c)
#pragma unroll
            for (int g = 0; g < 4; ++g) {
                f32x4 v = {O[c][4 * g] * rs, O[c][4 * g + 1] * rs, O[c][4 * g + 2] * rs, O[c][4 * g + 3] * rs};
                *(s16x4*)(op + 32 * c + 8 * g) = cvt4(v);
            }
    }
    __syncthreads();
}

__device__ __forceinline__ void attn_phase(LAS unsigned char* lds, const float* const* in, unsigned char* ws, int vcu, int G, int tid, int wid, int lane) {
    const bf16_t* Qb = (const bf16_t*)(ws + WS_QKVUG); const bf16_t* Kb = Qb + (size_t)NTOK * SW; const bf16_t* Vb = Kb + (size_t)NTOK * SW;
    bf16_t* AO = (bf16_t*)(ws + WS_AO);
    float lam;
    { const float* q1 = in[3]; const float* k1 = in[4]; const float* q2 = in[5]; const float* k2 = in[6];
      float s1 = q1[lane] * k1[lane] + q1[lane + 64] * k1[lane + 64], s2 = q2[lane] * k2[lane] + q2[lane + 64] * k2[lane + 64];
      s1 = wave_sum(s1); s2 = wave_sum(s2); lam = __expf(s1) - __expf(s2) + LAMBDA_INIT; }
    const float* rel = in[14];
    int cur_h = -1;
    if (wid >= 4) __builtin_amdgcn_s_setprio(1);
    for (int p = vcu; p < 256; p += G) {
        const int bh = p >> 3, s = p & 7, b = bh >> 3, h = bh & 7;
        if (h != cur_h) {
            __syncthreads();
            int tid_o = tid; asm volatile("" : "+v"(tid_o));
            if (tid_o < 288) { const int n = tid_o - 32; int bucket;
                if (n < 16) bucket = n < 0 ? 0 : n; else { const int lg = 16 + (int)(logf((float)n * (1.0f / 16.0f)) / 2.0794415416798357f * 16.0f); bucket = lg < 31 ? lg : 31; }
                ((LAS float*)(lds + AT_TAB))[tid_o] = n < 0 ? NEG_BIG : rel[bucket * 8 + h] * LOG2E; }
            __syncthreads(); cur_h = h;
        }
        attn_unit(lds, Qb, Kb, Vb, AO, b, h, 15 - s, lam, tid, wid, lane);
        attn_unit(lds, Qb, Kb, Vb, AO, b, h, s, lam, tid, wid, lane);
    }
    __builtin_amdgcn_s_setprio(0);
}
constexpr int GM_STAT = 131072;
constexpr int GM_RED = 132096;
constexpr int GM_W = 65536;

__device__ __forceinline__ int gm_voff(int s, int c8) { return s * 512 + 16 * (c8 ^ (((s & 3) << 1) | (((s >> 3) & 1) << 3))); }

__device__ __forceinline__ void gmlp_unit(LAS unsigned char* lds, const float* const* in, unsigned char* ws, int b, int ch, int h, int tid_in, int wid, int lane_in) {
    int tid = tid_in; asm volatile("" : "+v"(tid)); const int lane = tid & 63;
    const bf16_t* U = (const bf16_t*)(ws + WS_QKVUG) + (size_t)3 * NTOK * SW; const bf16_t* GG = U + (size_t)NTOK * SW;
    const float* gstat = (const float*)(ws + WS_GSTAT);
    bf16_t* AO = (bf16_t*)(ws + WS_AO); float* gpart = (float*)(ws + WS_GPART);
    const float* ln_g = in[9]; const float* ln_b = in[10]; const float* spw = in[11]; const float* spb = in[12];
    const size_t R0 = (size_t)b * SEQ + (size_t)ch * 128;
    LAS float* st = (LAS float*)(lds + GM_STAT); LAS float* red = (LAS float*)(lds + GM_RED);
    __syncthreads();
    if (tid < 128) { const float* gp = gstat + (R0 + tid) * 64; float s1 = 0.f, s2 = 0.f;
#pragma unroll
        for (int p = 0; p < 32; ++p) { s1 += gp[2 * p]; s2 += gp[2 * p + 1]; }
        const float mean = s1 * (1.0f / SW), var = fmaxf(s2 * (1.0f / SW) - mean * mean, 0.f);
        st[2 * tid] = mean; st[2 * tid + 1] = __builtin_amdgcn_rsqf(var + LN_EPS); }
    __syncthreads();
    const int tl = lane & 15, g4 = lane >> 4, q4 = (lane & 15) >> 2, p4 = lane & 3;
#pragma unroll
    for (int i = 0; i < 8; ++i) {
        const int idx = tid + 512 * i, s = idx >> 5, c8 = idx & 31; const int col = h * 256 + 8 * c8;
        const u32x4 raw = *(const u32x4*)(GG + (R0 + s) * SW + col);
        const f32x4 ga = *(const f32x4*)(ln_g + col), gb = *(const f32x4*)(ln_g + col + 4), ba = *(const f32x4*)(ln_b + col), bb = *(const f32x4*)(ln_b + col + 4);
        const float mean = st[2 * s], rstd = st[2 * s + 1];
        f32x8 v;
        v[0] = (__uint_as_float(raw.x << 16) - mean) * rstd * ga[0] + ba[0]; v[1] = (__uint_as_float(raw.x & 0xffff0000u) - mean) * rstd * ga[1] + ba[1];
        v[2] = (__uint_as_float(raw.y << 16) - mean) * rstd * ga[2] + ba[2]; v[3] = (__uint_as_float(raw.y & 0xffff0000u) - mean) * rstd * ga[3] + ba[3];
        v[4] = (__uint_as_float(raw.z << 16) - mean) * rstd * gb[0] + bb[0]; v[5] = (__uint_as_float(raw.z & 0xffff0000u) - mean) * rstd * gb[1] + bb[1];
        v[6] = (__uint_as_float(raw.w << 16) - mean) * rstd * gb[2] + bb[2]; v[7] = (__uint_as_float(raw.w & 0xffff0000u) - mean) * rstd * gb[3] + bb[3];
        *(LAS bf16x8*)(lds + gm_voff(s, c8)) = cvt8(v);
    }
#pragma unroll
    for (int i = 0; i < 4; ++i) {
        const int idx = tid + 512 * i, t = idx >> 4, c = idx & 15;
        const float* wp = spw + ((size_t)h * 128 + t) * 128 + 8 * c;
        const f32x4 a = *(const f32x4*)wp, b4 = *(const f32x4*)(wp + 4);
        f32x8 w = {a[0], a[1], a[2], a[3], b4[0], b4[1], b4[2], b4[3]};
#pragma unroll
        for (int j = 0; j < 8; ++j) w[j] = (8 * c + j <= t) ? w[j] : 0.f;
        *(LAS bf16x8*)(lds + GM_W + t * 272 + 16 * c) = cvt8(w);
    }
    __syncthreads();
    f32x4 acc[8][2];
#pragma unroll
    for (int mt = 0; mt < 8; ++mt)
#pragma unroll
        for (int nl = 0; nl < 2; ++nl) acc[mt][nl] = (f32x4){0.f, 0.f, 0.f, 0.f};
    u32x2 ur[8][2]; float bsv[8];
#pragma unroll
    for (int mt = 0; mt < 8; ++mt) { const int t_in = 16 * mt + tl; bsv[mt] = spb[h * 128 + t_in];
#pragma unroll
        for (int nl = 0; nl < 2; ++nl) ur[mt][nl] = *(const u32x2*)(U + (R0 + t_in) * SW + h * 256 + 16 * (2 * wid + nl) + 4 * g4); }
#pragma unroll
    for (int ks = 0; ks < 4; ++ks) {
        bf16x8 vf[2];
#pragma unroll
        for (int nl = 0; nl < 2; ++nl) {
            const int c = 2 * wid + nl, r0 = 32 * ks + 8 * g4 + q4;
            const s16x4 lo = __builtin_amdgcn_ds_read_tr16_b64_v4i16((LAS s16x4*)(lds + gm_voff(r0, 2 * c + (p4 >> 1)) + 8 * (p4 & 1)));
            const s16x4 hi = __builtin_amdgcn_ds_read_tr16_b64_v4i16((LAS s16x4*)(lds + gm_voff(r0 + 4, 2 * c + (p4 >> 1)) + 8 * (p4 & 1)));
            vf[nl] = __builtin_shufflevector(lo, hi, 0, 1, 2, 3, 4, 5, 6, 7);
        }
#pragma unroll
        for (int mt = 2 * ks; mt < 8; ++mt) {
            const bf16x8 wf = *(const LAS bf16x8*)(lds + GM_W + (16 * mt + tl) * 272 + (32 * ks + 8 * g4) * 2);
#pragma unroll
            for (int nl = 0; nl < 2; ++nl) acc[mt][nl] = MFMA16(vf[nl], wf, acc[mt][nl]);
        }
    }
#pragma unroll
    for (int mt = 0; mt < 8; ++mt) {
        const int t_in = 16 * mt + tl; const float bs = bsv[mt]; float ssq = 0.f;
#pragma unroll
        for (int nl = 0; nl < 2; ++nl) {
            const int col = h * 256 + 16 * (2 * wid + nl) + 4 * g4;
            const u32x2 uq = ur[mt][nl];
            f32x4 g;
            g[0] = __uint_as_float(uq.x << 16) * (acc[mt][nl][0] + bs); g[1] = __uint_as_float(uq.x & 0xffff0000u) * (acc[mt][nl][1] + bs);
            g[2] = __uint_as_float(uq.y << 16) * (acc[mt][nl][2] + bs); g[3] = __uint_as_float(uq.y & 0xffff0000u) * (acc[mt][nl][3] + bs);
            ssq += (g[0] * g[0] + g[1] * g[1]) + (g[2] * g[2] + g[3] * g[3]);
            *(s16x4*)(AO + (R0 + t_in) * DM + col) = cvt4(g);
        }
        ssq += __shfl_xor(ssq, 16); ssq += __shfl_xor(ssq, 32);
        if (g4 == 0) red[wid * 128 + t_in] = ssq;
    }
    __syncthreads();
    if (tid < 128) { float tot = 0.f;
#pragma unroll
        for (int w = 0; w < 8; ++w) tot += red[w * 128 + tid];
        gpart[(R0 + tid) * 8 + h] = tot; }
}

__device__ __forceinline__ void gmlp_phase(LAS unsigned char* lds, const float* const* in, unsigned char* ws, int vcu, int G, int tid, int wid, int lane) {
    for (int u = vcu; u < 512; u += G) gmlp_unit(lds, in, ws, u >> 7, (u >> 3) & 15, u & 7, tid, wid, lane);
}
constexpr int RT_STAT = 0;
constexpr int RT_PART = 1024;
constexpr int RT_LOGIT = 1024 + 8 * 32 * 80 * 4;

__device__ __forceinline__ void route_unit(LAS unsigned char* lds, const float* const* in, float* zout, unsigned char* ws, int rgp, int tid, int wid, int lane) {
    const bf16_t* Y = (const bf16_t*)(ws + WS_Y); bf16_t* X1B = (bf16_t*)(ws + WS_X1B);
    const bf16_t* WRT = (const bf16_t*)(ws + WS_WRT);
    const float* g1 = in[15]; const float* b1 = in[16];
    LAS float* st = (LAS float*)(lds + RT_STAT); LAS float* part = (LAS float*)(lds + RT_PART); LAS float* logit = (LAS float*)(lds + RT_LOGIT);
    const int row0 = rgp * 32;
    __syncthreads();
    { const float* ystat = (const float*)(ws + WS_YSTAT); const int r = tid >> 4, sub = tid & 15;
      const f32x4* yp = (const f32x4*)(ystat + ((size_t)(row0 + r) * 64 + sub * 4) * 2);
      const f32x4 a = yp[0], b = yp[1];
      float s1 = (a[0] + a[2]) + (b[0] + b[2]), s2 = (a[1] + a[3]) + (b[1] + b[3]);
#pragma unroll
      for (int o = 1; o < 16; o <<= 1) { s1 += __shfl_xor(s1, o); s2 += __shfl_xor(s2, o); }
      if (sub == 0) { const float mean = s1 * (1.0f / DM), var = fmaxf(s2 * (1.0f / DM) - mean * mean, 0.f); st[2 * r] = mean; st[2 * r + 1] = __builtin_amdgcn_rsqf(var + LN_EPS); } }
    __syncthreads();
    const int tl = lane & 15, g4 = lane >> 4;
    f32x4 acc[2][5];
#pragma unroll
    for (int mt = 0; mt < 2; ++mt)
#pragma unroll
        for (int nt = 0; nt < 5; ++nt) acc[mt][nt] = (f32x4){0.f, 0.f, 0.f, 0.f};
    float mean[2], rstd[2];
#pragma unroll
    for (int mt = 0; mt < 2; ++mt) { mean[mt] = st[2 * (16 * mt + tl)]; rstd[mt] = st[2 * (16 * mt + tl) + 1]; }
#pragma unroll 2
    for (int ks = 0; ks < 16; ++ks) {
        const int k0 = 512 * wid + 32 * ks + 8 * g4;
        const f32x4 ga = *(const f32x4*)(g1 + k0), gb = *(const f32x4*)(g1 + k0 + 4), ba = *(const f32x4*)(b1 + k0), bb = *(const f32x4*)(b1 + k0 + 4);
        bf16x8 ah[2], al[2];
#pragma unroll
        for (int mt = 0; mt < 2; ++mt) {
            const size_t off = (size_t)(row0 + 16 * mt + tl) * DM + k0;
            const u32x4 yr = *(const u32x4*)(Y + off);
            const f32x4 ya = {__uint_as_float(yr.x << 16), __uint_as_float(yr.x & 0xffff0000u), __uint_as_float(yr.y << 16), __uint_as_float(yr.y & 0xffff0000u)};
            const f32x4 yb = {__uint_as_float(yr.z << 16), __uint_as_float(yr.z & 0xffff0000u), __uint_as_float(yr.w << 16), __uint_as_float(yr.w & 0xffff0000u)};
            f32x8 x;
#pragma unroll
            for (int j = 0; j < 4; ++j) { x[j] = (ya[j] - mean[mt]) * rstd[mt] * ga[j] + ba[j]; x[4 + j] = (yb[j] - mean[mt]) * rstd[mt] * gb[j] + bb[j]; }
            const bf16x8 hi = cvt8(x); ah[mt] = hi;
            *(bf16x8*)(X1B + off) = hi;
            f32x8 lo;
#pragma unroll
            for (int j = 0; j < 8; ++j) lo[j] = x[j] - __uint_as_float(((unsigned)(unsigned short)hi[j]) << 16);
            al[mt] = cvt8(lo);
        }
#pragma unroll
        for (int nt = 0; nt < 5; ++nt) {
            const bf16x8 wh = *(const bf16x8*)(WRT + (size_t)(16 * nt + tl) * DM + k0), wl = *(const bf16x8*)(WRT + (size_t)(80 + 16 * nt + tl) * DM + k0);
#pragma unroll
            for (int mt = 0; mt < 2; ++mt) { acc[mt][nt] = MFMA16(ah[mt], wh, acc[mt][nt]); acc[mt][nt] = MFMA16(ah[mt], wl, acc[mt][nt]); acc[mt][nt] = MFMA16(al[mt], wh, acc[mt][nt]); }
        }
    }
#pragma unroll
    for (int mt = 0; mt < 2; ++mt)
#pragma unroll
        for (int nt = 0; nt < 5; ++nt)
#pragma unroll
            for (int i = 0; i < 4; ++i) part[(wid * 32 + 16 * mt + 4 * g4 + i) * 80 + 16 * nt + tl] = acc[mt][nt][i];
    __syncthreads();
    for (int idx = tid; idx < 32 * 80; idx += 512) { float s = 0.f;
#pragma unroll
        for (int w = 0; w < 8; ++w) s += part[w * 2560 + idx];
        logit[idx] = s; }
    __syncthreads();
    if (tid < 32) {
        const float* bg = in[18]; const float* be = in[20];
        const LAS float* lg = logit + tid * 80;
        float gl[8]; int gi = 0; float gm = -3.0e38f;
#pragma unroll
        for (int j = 0; j < 8; ++j) { gl[j] = lg[j] + bg[j]; if (gl[j] > gm) { gm = gl[j]; gi = j; } }
        float den = 0.f;
#pragma unroll
        for (int j = 0; j < 8; ++j) den += __expf(gl[j] - gm);
        const float gw = 1.0f / den;
        float t1 = -3.0e38f, t2 = -3.0e38f; int i1 = 0, i2 = 0;
        for (int j = 0; j < 8; ++j) { const float v = lg[8 + 8 * gi + j] + be[8 * gi + j];
            if (v > t1) { t2 = t1; i2 = i1; t1 = v; i1 = j; } else if (v > t2) { t2 = v; i2 = j; } }
        const float e2 = __expf(t2 - t1), w1 = 1.0f / (1.0f + e2), w2 = e2 * w1;
        const int token = row0 + tid, e0 = 8 * gi + i1, e1 = 8 * gi + i2;
        unsigned* cnt = (unsigned*)(ws + WS_CTL) + CW_CNT;
        int* tokl = (int*)(ws + WS_TOKL); float* wl = (float*)(ws + WS_WL);
        const int p0 = (int)atomicAdd(cnt + 32 * e0, 1u), p1 = (int)atomicAdd(cnt + 32 * e1, 1u);
        tokl[e0 * NTOK + p0] = token; wl[e0 * NTOK + p0] = gw * w1;
        tokl[e1 * NTOK + p1] = token; wl[e1 * NTOK + p1] = gw * w2;
        ((i32x4*)(ws + WS_ROUTE))[token] = (i32x4){e0, p0, e1, p1};
    }
}

namespace egC {
#ifndef EG_WAUX
#define EG_WAUX 2
#endif
constexpr int EG_ROWS = 320, EG_MT = EG_ROWS / 16;
constexpr int EG_NW = 4, EG_PFW = 3, EG_UNR = 4, EG_WSTG = 16384, EG_ASTG = EG_ROWS * 128;
constexpr int EG_AOFF = EG_NW * EG_WSTG, EG_WLOFF = EG_AOFF + 2 * EG_ASTG, EG_CNTOFF = EG_WLOFF + EG_ROWS * 4;
static_assert(EG_CNTOFF + 768 <= MISC_OFF && EG_UNR % EG_NW == 0 && EG_PFW == EG_NW - 1, "expert GEMM LDS map / ring geometry");

template <int MODE>
__device__ __forceinline__ void eg_unit(LAS unsigned char* lds, const float* const* in, unsigned char* ws, int e, int ugrp, int cnt, int base, int tid_in, int wid, int lane_in) {
    constexpr int K = MODE == 0 ? DM : DFF, LDB = MODE == 0 ? DFF : DM, KST = K / 32, NTG = MODE == 0 ? 1 : 2, TS = KST * NTG;
    constexpr int WROW = MODE == 0 ? 256 : 512;
    int lane; asm volatile("v_mbcnt_lo_u32_b32 %0, -1, 0\n\tv_mbcnt_hi_u32_b32 %0, -1, %0" : "=v"(lane));
    const int tid = wid * 64 + lane;
    bf16_t* H = (bf16_t*)(ws + WS_H); unsigned char* YS = ws + WS_YS;
    const int* tokl = (const int*)(ws + WS_TOKL) + (size_t)e * NTOK; const float* wlst = (const float*)(ws + WS_WL) + (size_t)e * NTOK;
    const int tl = lane & 15, g4 = lane >> 4;
    const bool consumer = wid < 4, wloader = (wid == 4 || wid == 5);
    const int cg = wid & 1, rh = (wid >> 1) & 1;
    const int wl = wid & 1, al = wid & 1;
    const float* wm0 = (MODE == 0 ? in[21] : in[23]) + (size_t)e * DM * DFF; const float* wm1 = (MODE == 0 ? in[22] : in[23]) + (size_t)e * DM * DFF;
    const __amdgpu_buffer_rsrc_t wrs0 = __builtin_amdgcn_make_buffer_rsrc((void*)wm0, 0, DM * DFF * 4, 0x00020000);
    const __amdgpu_buffer_rsrc_t wrs1 = __builtin_amdgcn_make_buffer_rsrc((void*)wm1, 0, DM * DFF * 4, 0x00020000);
    unsigned wvo[2];
#pragma unroll
    for (int x = 0; x < 2; ++x) wvo[x] = MODE == 0 ? (unsigned)((((16 * wl + (lane >> 4)) * LDB) + 4 * ((lane & 15) ^ x)) * 4) : (unsigned)((((16 * wl + (lane >> 5)) * LDB) + 4 * ((lane & 31) ^ x)) * 4);
    const __amdgpu_buffer_rsrc_t ars = __builtin_amdgcn_make_buffer_rsrc(MODE == 0 ? (void*)(ws + WS_X1B) : (void*)(ws + WS_H), 0, MODE == 0 ? NTOK * DM * 2 : 2 * NTOK * DFF * 2, 0x00020000);
    int wfo[4];
#pragma unroll
    for (int t = 0; t < 4; ++t) { const int chunk = MODE == 0 ? 8 * cg + 2 * (tl >> 2) + (t & 1) : 16 * cg + 4 * (tl >> 2) + t;
        wfo[t] = (MODE == 0 ? (t >> 1) * 8192 : 0) + (8 * g4) * WROW + 16 * (chunk ^ (g4 & 1)) + 4 * (tl & 3); }
    const int aoff0 = EG_AOFF + rh * 2048 + tl * 128 + 16 * (g4 ^ (tl & 7)), aoff1 = EG_AOFF + rh * 2048 + tl * 128 + 16 * ((4 + g4) ^ (tl & 7));
    LAS float* wl_lds = (LAS float*)(lds + EG_WLOFF);

    for (int rowp = 0; rowp < cnt; rowp += EG_ROWS) {
        const int nrows = (cnt - rowp) < EG_ROWS ? (cnt - rowp) : EG_ROWS, n_mt = (nrows + 15) >> 4;
        const bool keep = (cnt - rowp) > EG_ROWS;
        const int n_act = n_mt > rh ? (n_mt - rh + 1) >> 1 : 0;
        const int npc_ = (nrows - 160 * al + 7) >> 3; const int npc = npc_ < 0 ? 0 : (npc_ > 20 ? 20 : npc_);
        __syncthreads();
        if (MODE == 1) { if (tid < EG_ROWS) wl_lds[tid] = tid < nrows ? wlst[rowp + tid] : 0.f; }
        f32x4 acc[4][EG_MT / 2];
#define EG_STEP_BARRIER() do { __builtin_amdgcn_s_barrier(); asm volatile("" ::: "memory"); } while (0)
        if (wloader) {
#define EG_DMA_W(rs_, dst_, vo_, so_x) do { if (keep) __builtin_amdgcn_raw_ptr_buffer_load_lds(rs_, (LAS unsigned*)(dst_), 16, vo_, so_x, 0, 0); else __builtin_amdgcn_raw_ptr_buffer_load_lds(rs_, (LAS unsigned*)(dst_), 16, vo_, so_x, 0, EG_WAUX); } while (0)
#define EG_ISSUE_W(s_) do { const int s__ = (s_) < TS ? (s_) : TS - 1; LAS unsigned char* st_ = lds + ((s_) % EG_NW) * EG_WSTG; \
        if (MODE == 0) { const int so_ = ((s__ % KST) * 32 * LDB + ugrp * 64) * 4; \
            _Pragma("unroll") for (int jj = 0; jj < 4; ++jj) { \
                EG_DMA_W(wrs0, st_ + (4 * wl + jj) * 1024, wvo[(jj >> 1) & 1], so_ + jj * (4 * LDB * 4)); \
                EG_DMA_W(wrs1, st_ + 8192 + (4 * wl + jj) * 1024, wvo[(jj >> 1) & 1], so_ + jj * (4 * LDB * 4)); } } \
        else { const int so_ = ((s__ % KST) * 32 * LDB + ugrp * (NTG * 128) + (s__ / KST) * 128) * 4; \
            _Pragma("unroll") for (int jj = 0; jj < 8; ++jj) EG_DMA_W(wrs0, st_ + (8 * wl + jj) * 1024, wvo[(jj >> 2) & 1], so_ + jj * (2 * LDB * 4)); } } while (0)
            asm volatile("s_waitcnt vmcnt(0) lgkmcnt(0)" ::: "memory");
#pragma unroll
            for (int u = 0; u < EG_PFW; ++u) EG_ISSUE_W(u);
            asm volatile("s_waitcnt vmcnt(%0)" :: "n"(8 * (EG_PFW - 1)) : "memory");
            EG_STEP_BARRIER();
#pragma unroll 1
            for (int s = 0; s < TS; ++s) {
                EG_ISSUE_W(s + EG_PFW);
                asm volatile("s_waitcnt vmcnt(%0)" :: "n"(8 * (EG_PFW - 1)) : "memory");
                EG_STEP_BARRIER();
            }
#undef EG_ISSUE_W
#undef EG_DMA_W
        } else if (!consumer) {
            unsigned avo[20];
#pragma unroll
            for (int jj = 0; jj < 20; ++jj) { const int lr = 160 * al + 8 * jj + (lane >> 3); const int lrc = lr < nrows ? lr : 0;
                const unsigned ro = MODE == 0 ? (unsigned)tokl[rowp + lrc] * (DM * 2) : (unsigned)(base + rowp + lrc) * (DFF * 2);
                avo[jj] = ro + 16 * ((lane & 7) ^ ((lane >> 3) & 7)); }
            asm volatile("s_waitcnt vmcnt(0) lgkmcnt(0)" ::: "memory");
#define EG_ISSUE_A(j_) do { LAS unsigned char* st_ = lds + EG_AOFF + ((j_) & 1) * EG_ASTG + (20 * al) * 1024; const int so_ = ((j_) % (KST / 2)) * 128; \
        _Pragma("unroll") for (int jj = 0; jj < 20; ++jj) if (jj < npc) __builtin_amdgcn_raw_ptr_buffer_load_lds(ars, (LAS unsigned*)(st_ + jj * 1024), 16, avo[jj], so_, 0, 0); } while (0)
            EG_ISSUE_A(0);
            asm volatile("s_waitcnt vmcnt(0)" ::: "memory");
            EG_STEP_BARRIER();
#pragma unroll 1
            for (int s = 0; s < TS; s += 2) {
                if ((s >> 1) + 1 < TS / 2) EG_ISSUE_A((s >> 1) + 1);
                EG_STEP_BARRIER();
                asm volatile("s_waitcnt vmcnt(0)" ::: "memory");
                EG_STEP_BARRIER();
            }
#undef EG_ISSUE_A
        } else {
#pragma unroll
            for (int t = 0; t < 4; ++t)
#pragma unroll
                for (int i = 0; i < EG_MT / 2; ++i) acc[t][i] = (f32x4){0.f, 0.f, 0.f, 0.f};
            __builtin_amdgcn_s_waitcnt(0x0070);
            asm volatile("" ::: "memory");
            EG_STEP_BARRIER();
#pragma unroll 1
            for (int s0 = 0; s0 < TS; s0 += EG_UNR) {
#pragma unroll
                for (int u = 0; u < EG_UNR; ++u) {
                    const int s = s0 + u;
                    const LAS unsigned char* wsb = lds + (u % EG_NW) * EG_WSTG;
                    bf16x8 wf[4];
#pragma unroll
                    for (int t = 0; t < 4; ++t) { f32x8 wv;
#pragma unroll
                        for (int j = 0; j < 8; ++j) wv[j] = *(const LAS float*)(wsb + wfo[t] + j * WROW);
                        wf[t] = cvt8(wv); }
                    const LAS unsigned char* ab = lds + ((u >> 1) & 1) * EG_ASTG + ((u & 1) ? aoff1 : aoff0);
                    bf16x8 xf[2][2];
#pragma unroll
                    for (int q = 0; q < 2; ++q) xf[0][q] = *(const LAS bf16x8*)(ab + q * 4096);
#pragma unroll
                    for (int gq = 0; gq < EG_MT / 4; ++gq) {
                        if (gq + 1 < EG_MT / 4) { if (2 * (gq + 1) < n_act) {
#pragma unroll
                            for (int q = 0; q < 2; ++q) xf[(gq + 1) & 1][q] = *(const LAS bf16x8*)(ab + (2 * (gq + 1) + q) * 4096); } }
                        __builtin_amdgcn_sched_barrier(0);
                        if (2 * gq < n_act) {
#pragma unroll
                            for (int q = 0; q < 2; ++q)
#pragma unroll
                                for (int t = 0; t < 4; ++t) acc[t][2 * gq + q] = MFMA16(wf[t], xf[gq & 1][q], acc[t][2 * gq + q]); }
                        __builtin_amdgcn_sched_barrier(0);
                    }
                    if (MODE == 1) { if ((s % KST) == KST - 1) {
                        const int col = ugrp * (NTG * 128) + (s / KST) * 128 + 64 * cg + 16 * g4;
                        int tlo = tl; asm volatile("" : "+v"(tlo));
#pragma unroll
                        for (int j = 0; j < EG_MT / 2; ++j) { if (j < n_act) { const int lr = 16 * (2 * j + rh) + tlo; const float wgt = wl_lds[lr] * YS_SCALE;
                                u32x4 o;
#pragma unroll
                                for (int t = 0; t < 4; ++t) { const f32x4 a = acc[t][j] * wgt; int pk = 0;
                                    pk = __builtin_amdgcn_cvt_pk_fp8_f32(__builtin_amdgcn_fmed3f(a[0], -448.f, 448.f), __builtin_amdgcn_fmed3f(a[1], -448.f, 448.f), pk, false);
                                    pk = __builtin_amdgcn_cvt_pk_fp8_f32(__builtin_amdgcn_fmed3f(a[2], -448.f, 448.f), __builtin_amdgcn_fmed3f(a[3], -448.f, 448.f), pk, true);
                                    o[t] = (unsigned)pk; }
                                if (lr < nrows) *(u32x4*)(YS + (size_t)(base + rowp + lr) * DM + col) = o; }
#pragma unroll
                            for (int t = 0; t < 4; ++t) acc[t][j] = (f32x4){0.f, 0.f, 0.f, 0.f}; } } }
                    asm volatile("s_waitcnt lgkmcnt(0)" ::: "memory");
                    EG_STEP_BARRIER();
                }
            }
            if (MODE == 0) {
            const int col = ugrp * 64 + 32 * cg + 8 * g4;
#pragma unroll
            for (int j = 0; j < EG_MT / 2; ++j) if (j < n_act) { const int lr = 16 * (2 * j + rh) + tl;
                if (lr < nrows) { f32x8 hv;
#pragma unroll
                    for (int hf = 0; hf < 2; ++hf)
#pragma unroll
                        for (int i = 0; i < 4; ++i) { const float v = acc[hf][j][i]; hv[4 * hf + i] = v / (1.0f + __expf(-v)) * acc[2 + hf][j][i]; }
                    *(bf16x8*)(H + (size_t)(base + rowp + lr) * DFF + col) = cvt8(hv); } }
            }
        }
#undef EG_STEP_BARRIER
        asm volatile("s_waitcnt vmcnt(0)" ::: "memory");
        __syncthreads();
#undef EG_ISSUE_W
#undef EG_ISSUE_A
    }
}

template <int MODE>
__device__ __forceinline__ void eg_phase(LAS unsigned char* lds, const float* const* in, unsigned char* ws, int vcu, int G, int tid, int wid, int lane) {
    LAS int* ecnt = (LAS int*)(lds + EG_CNTOFF); LAS int* ebase = ecnt + 64;
    __syncthreads();
    if (tid < 64) { const unsigned* cnt = (const unsigned*)(ws + WS_CTL) + CW_CNT; int c = (int)cnt[32 * tid]; ecnt[tid] = c; }
    __syncthreads();
    if (tid < 64) { int s = 0; for (int j = 0; j < tid; ++j) s += ecnt[j]; ebase[tid] = s; }
    __syncthreads();
    LAS int* eord = ebase + 64;
    if (tid < 64) { const int c = ecnt[tid]; int r = 0;
        for (int j = 0; j < 64; ++j) { const int cj = ecnt[j]; r += (cj > c || (cj == c && j < tid)) ? 1 : 0; }
        eord[r] = tid; }
    __syncthreads();
    if (G == 256 && MODE == 0) {
        for (int k = 0; k < 2; ++k) { const int e = eord[k == 0 ? (vcu >> 3) : 63 - (vcu >> 3)], ug = vcu & 7; const int c = ecnt[e]; if (c > 0) eg_unit<MODE>(lds, in, ws, e, ug, c, ebase[e], tid, wid, lane); }
    } else if (G == 256) {
        for (int k = 0; k < 4; ++k) { const int i = vcu >> 4, ug = vcu & 15; const int e = eord[k == 0 ? i : (k == 1 ? 63 - i : (k == 2 ? 31 - i : 32 + i))]; const int c = ecnt[e]; if (c > 0) eg_unit<MODE>(lds, in, ws, e, ug, c, ebase[e], tid, wid, lane); }
    } else {
        constexpr int NU = MODE == 0 ? 8 : 16;
        for (int u = vcu; u < NEXP * NU; u += G) { const int e = u / NU, ug = u % NU; const int c = ecnt[e]; if (c > 0) eg_unit<MODE>(lds, in, ws, e, ug, c, ebase[e], tid, wid, lane); }
    }
}
}
constexpr int EG_CNTOFF = egC::EG_CNTOFF;
__device__ __forceinline__ void final_phase(LAS unsigned char* lds, const float* const* in, float* out, unsigned char* ws, int vcu, int G, int tid, int wid, int lane) {
    LAS int* ecnt = (LAS int*)(lds + EG_CNTOFF); LAS int* ebase = ecnt + 64;
    __syncthreads();
    if (tid < 64) { const unsigned* cnt = (const unsigned*)(ws + WS_CTL) + CW_CNT; ecnt[tid] = (int)cnt[32 * tid]; }
    __syncthreads();
    if (tid < 64) { int s = 0; for (int j = 0; j < tid; ++j) s += ecnt[j]; ebase[tid] = s; }
    __syncthreads();
    const unsigned char* YS = ws + WS_YS; const bf16_t* X1B = (const bf16_t*)(ws + WS_X1B); const float* g2 = in[24]; const float* b2 = in[25];
    for (int row = vcu * 8 + wid; row < NTOK; row += G * 8) {
        const i32x4 rt = ((const i32x4*)(ws + WS_ROUTE))[row];
        const int a0 = ebase[rt[0]] + rt[1], a1 = ebase[rt[2]] + rt[3];
        f32x4* zp = (f32x4*)(out + (size_t)row * DM) + lane;
        const u32x2* xp = (const u32x2*)(X1B + (size_t)row * DM) + lane;
        const unsigned* y0 = (const unsigned*)(YS + (size_t)a0 * DM) + lane; const unsigned* y1 = (const unsigned*)(YS + (size_t)a1 * DM) + lane;
        f32x4 v[16]; float s = 0.f;
#pragma unroll
        for (int j = 0; j < 16; ++j) { const u32x2 z = xp[64 * j]; const int p = (int)y0[64 * j], q = (int)y1[64 * j];
            v[j][0] = ALPHA * __uint_as_float(z.x << 16) + (__builtin_amdgcn_cvt_f32_fp8(p, 0) + __builtin_amdgcn_cvt_f32_fp8(q, 0)) * (1.0f / YS_SCALE);
            v[j][1] = ALPHA * __uint_as_float(z.x & 0xffff0000u) + (__builtin_amdgcn_cvt_f32_fp8(p, 1) + __builtin_amdgcn_cvt_f32_fp8(q, 1)) * (1.0f / YS_SCALE);
            v[j][2] = ALPHA * __uint_as_float(z.y << 16) + (__builtin_amdgcn_cvt_f32_fp8(p, 2) + __builtin_amdgcn_cvt_f32_fp8(q, 2)) * (1.0f / YS_SCALE);
            v[j][3] = ALPHA * __uint_as_float(z.y & 0xffff0000u) + (__builtin_amdgcn_cvt_f32_fp8(p, 3) + __builtin_amdgcn_cvt_f32_fp8(q, 3)) * (1.0f / YS_SCALE);
            s += (v[j][0] + v[j][1]) + (v[j][2] + v[j][3]); }
        const float mean = wave_sum(s) * (1.0f / DM); float q2 = 0.f;
#pragma unroll
        for (int j = 0; j < 16; ++j) { v[j] = v[j] - mean; q2 += (v[j][0] * v[j][0] + v[j][1] * v[j][1]) + (v[j][2] * v[j][2] + v[j][3] * v[j][3]); }
        const float rstd = __builtin_amdgcn_rsqf(wave_sum(q2) * (1.0f / DM) + LN_EPS);
        int lo_ = lane; asm volatile("" : "+v"(lo_));
        const f32x4* g2p = (const f32x4*)g2 + lo_; const f32x4* b2p = (const f32x4*)b2 + lo_;
#pragma unroll
        for (int j = 0; j < 16; ++j) { const f32x4 gg = g2p[64 * j], bb = b2p[64 * j]; zp[64 * j] = v[j] * rstd * gg + bb;
            if ((j & 3) == 3) asm volatile("" ::: "memory"); }
    }
}
#ifndef MK_N_LAUNCHES
#define MK_N_LAUNCHES 1
#endif
constexpr int N_PHASES = 8;
struct Args { const float* in[26]; float* out; unsigned char* ws; int ph_lo, ph_hi; };

__global__ void __launch_bounds__(512, 2) mk_fwd(Args args) {
    extern __shared__ __attribute__((aligned(16))) unsigned char lds_raw[];
    LAS unsigned char* lds = (LAS unsigned char*)lds_raw;
    const int wid = __builtin_amdgcn_readfirstlane(threadIdx.x >> 6);
#define FRESH_TID() int lane; asm volatile("v_mbcnt_lo_u32_b32 %0, -1, 0\n\tv_mbcnt_hi_u32_b32 %0, -1, %0" : "=v"(lane)); const int tid = wid * 64 + lane;
    const int G = gridDim.x, bx = blockIdx.x;
    const int vcu = (G % 8 == 0) ? (bx % 8) * (G / 8) + bx / 8 : bx;
    unsigned char* ws = args.ws;
    unsigned* ctl = (unsigned*)(ws + WS_CTL);
    volatile LAS unsigned* MISC = (volatile LAS unsigned*)(lds + MISC_OFF);
    { FRESH_TID(); if (tid < 32) MISC[tid] = 0u; }
    __syncthreads();
    const int lo = args.ph_lo, hi = args.ph_hi;
    XcdBarrier bar; bar.bar = ctl + CW_BAR + lo * XCD_BAR_WORDS; bar.x = 0; bar.st = MISC + 8; bar.w = (unsigned)wid;
    if (hi - lo > 1) bar = xcd_barrier_post(ctl + CW_BAR + lo * XCD_BAR_WORDS, MISC + 8);
#ifndef MK_PHASE_MASK
#define MK_PHASE_MASK 255
#endif
#define IN(k) ((((MK_PHASE_MASK) >> (k)) & 1) && lo <= (k) && (k) < hi)
#define SEAM(k) do { if (IN(k) && IN((k) + 1)) xcd_barrier(bar); } while (0)
#ifndef MK_DUP
#define MK_DUP -1
#endif
#define REP(k) for (int rep_ = 0; rep_ < ((MK_DUP) == (k) ? 2 : 1); ++rep_)

    if (IN(0)) REP(0) { FRESH_TID(); p0_prologue(lds, args.in, ws, vcu, G, tid, wid, lane); }
    SEAM(0);
    if (IN(1)) REP(1) {
        pg8::Gemm g{(const bf16_t*)(ws + WS_XB), (const bf16_t*)(ws + WS_WINT), NTOK, DIN, DM};
        pg8::StaticOrder S; S.init(NTOK, DIN, G, bx);
        EpiProj E{(bf16_t*)(ws + WS_QKVUG), (float*)(ws + WS_GSTAT)};
        pg8::gemm_phase<EpiProj, pg8::StaticOrder, true, true>(lds, g, S, E, wid);
    }
    SEAM(1);
    if (IN(2)) {
#ifndef MK_P2_SUB
#define MK_P2_SUB 3
#endif
        if (MK_P2_SUB & 1) REP(2) { FRESH_TID(); attn_phase(lds, args.in, ws, vcu, G, tid, wid, lane); }
        if (MK_P2_SUB & 2) REP(20) { FRESH_TID(); gmlp_phase(lds, args.in, ws, vcu, G, tid, wid, lane); }
    }
    SEAM(2);
    if (IN(3)) REP(3) {
        pg8::Gemm g{(const bf16_t*)(ws + WS_AO), (const bf16_t*)(ws + WS_WOUTT), NTOK, DM, DM};
        pg8::StaticOrder S; S.init(NTOK, DM, G, bx);
        EpiY E{(const bf16_t*)(ws + WS_XB), (bf16_t*)(ws + WS_Y), (float*)(ws + WS_YSTAT), (const float*)(ws + WS_GPART)};
        pg8::gemm_phase<EpiY, pg8::StaticOrder, true, true>(lds, g, S, E, wid);
    }
    SEAM(3);
    if (IN(4)) { FRESH_TID(); for (int rgp = vcu; rgp < NTOK / 32; rgp += G) route_unit(lds, args.in, args.out, ws, rgp, tid, wid, lane); }
    SEAM(4);
    if (IN(5)) REP(5) { FRESH_TID(); egC::eg_phase<0>(lds, args.in, ws, vcu, G, tid, wid, lane); }
    SEAM(5);
    if (IN(6)) REP(6) { FRESH_TID(); egC::eg_phase<1>(lds, args.in, ws, vcu, G, tid, wid, lane); }
    SEAM(6);
    if (IN(7)) { FRESH_TID(); final_phase(lds, args.in, args.out, ws, vcu, G, tid, wid, lane); }
#undef IN
#undef SEAM
}
}

extern "C" void kernel_launch(void* const* d_in, const int* in_sizes, int n_in, void* d_out, int out_size, void* d_ws, size_t ws_size, hipStream_t stream) {
    using namespace mk;
    static int grid = 0;
    if (grid == 0) {
        if (n_in != 26 || out_size != NTOK * DM || ws_size < WS_END) { fprintf(stderr, "kernel_launch: unexpected shapes (n_in %d, out %d, ws %zu)\n", n_in, out_size, ws_size); grid = -1; return; }
        int dev = 0, cus = 0, per_cu = 0;
        if (hipGetDevice(&dev) != hipSuccess || hipDeviceGetAttribute(&cus, hipDeviceAttributeMultiprocessorCount, dev) != hipSuccess) { grid = -1; return; }
        if (hipFuncSetAttribute((const void*)mk_fwd, hipFuncAttributeMaxDynamicSharedMemorySize, LDS_BYTES) != hipSuccess) { fprintf(stderr, "kernel_launch: hipFuncSetAttribute failed\n"); grid = -1; return; }
        if (hipOccupancyMaxActiveBlocksPerMultiprocessor(&per_cu, (const void*)mk_fwd, 512, LDS_BYTES) != hipSuccess || per_cu < 1)
            fprintf(stderr, "kernel_launch: note: occupancy query reports %d blocks per CU\n", per_cu);
        (void)hipGetLastError();
        grid = cus;
    }
    if (grid < 0) return;
    if (hipMemsetAsync((char*)d_ws + WS_CTL, 0, CTL_ZERO_BYTES, stream) != hipSuccess) return;
    Args a{};
    for (int i = 0; i < 26; ++i) a.in[i] = (const float*)d_in[i];
    a.out = (float*)d_out; a.ws = (unsigned char*)d_ws;
#if MK_N_LAUNCHES == 1
    a.ph_lo = 0; a.ph_hi = N_PHASES;
    hipLaunchKernelGGL(mk_fwd, dim3(grid), dim3(512), LDS_BYTES, stream, a);
#else
#ifndef MK_DUP_LAUNCH
#define MK_DUP_LAUNCH -1
#endif
    for (int p = 0; p < N_PHASES; ++p) { a.ph_lo = p; a.ph_hi = p + 1;
        for (int rep = 0; rep < (p == (MK_DUP_LAUNCH) ? 2 : 1); ++rep) hipLaunchKernelGGL(mk_fwd, dim3(grid), dim3(512), LDS_BYTES, stream, a); }
#endif
}
```

```cpp
#include <hip/hip_runtime.h>
#include <cstdio>
#include <cstdint>
namespace pg8 {
#define PG8_LAS __attribute__((address_space(3)))
typedef unsigned short bf16_t;
typedef short bf16x8 __attribute__((ext_vector_type(8)));
typedef float f32x4 __attribute__((ext_vector_type(4)));
typedef unsigned u32x4 __attribute__((ext_vector_type(4)));
constexpr int BM = 256, BK = 64, HALF = 128, HTB = HALF * BK * 2  , STAGE_BYTES = 8 * HTB, NXCD = 8, WGM = 8;

__host__ __device__ __forceinline__ int lds_byte(int r, int c) { const int st = (r >> 4) * 2 + (c >> 5), rr = r & 15, cc = c & 31, ob = rr * 64 + cc * 2; return st * 1024 + (ob ^ (((ob >> 9) & 1) << 5)); }
__host__ __device__ __forceinline__ void stage_rc(int b, int& R, int& C) { const int st = b / 1024, sb = b % 1024, swz = sb ^ (((sb >> 9) & 1) << 5); R = (st >> 1) * 16 + swz / 64; C = (st & 1) * 32 + (swz % 64) / 2; }
__host__ __device__ __forceinline__ int perm32(int rho) { const int n = rho >> 4, i = rho & 15; return 8 * (i >> 2) + 4 * n + (i & 3); }

struct Unit { int pm, pn; };
struct Gemm { const bf16_t* A; const bf16_t* Bt; int M, N, K; };

struct StaticOrder {
    int nM, nN, nwg, G, c;
    __host__ __device__ void init(int M, int N, int G_, int c_) { nM = M / BM; nN = N / BM; nwg = nM * nN; G = G_; c = c_; }
    __host__ __device__ bool next(int i, Unit& u) const {
        const long L = (long)i * G + c; if (L >= nwg) return false;
        int wgid = (int)L; { const int q = nwg / NXCD, r = nwg % NXCD, xcd = wgid % NXCD, off = wgid / NXCD; wgid = (xcd < r ? xcd * (q + 1) : r * (q + 1) + (xcd - r) * q) + off; }
        const int nig = WGM * nN, gid = wgid / nig, fm = gid * WGM, gsz = (nM - fm) < WGM ? (nM - fm) : WGM;
        u.pm = fm + ((wgid % nig) % gsz); u.pn = (wgid % nig) / gsz; return true;
    }
    __device__ __forceinline__ void a_ready(const Unit&) const {}
    __device__ __forceinline__ void done(const Unit&) const {}
};
__device__ __forceinline__ unsigned cvt_pk_bf16(float lo, float hi) { unsigned r; asm volatile("v_cvt_pk_bf16_f32 %0, %1, %2" : "=v"(r) : "v"(lo), "v"(hi)); return r; }
typedef float f32x2 __attribute__((ext_vector_type(2)));
__device__ __forceinline__ f32x2 gelu_pk(f32x2 v) {
    const f32x2 av = __builtin_elementwise_abs(v), d = av * 0.2316418882f + 1.0f;
    f32x2 t; t.x = __builtin_amdgcn_rcpf(d.x); t.y = __builtin_amdgcn_rcpf(d.y);
    f32x2 q = t * 0.5307027145f + (-0.7265760135f); q = q * t + 0.7107068705f; q = q * t + (-0.142248368f); q = q * t + 0.127414796f; q = q * t;
    const f32x2 s = (v * v) * (-0.72134752044f);
    f32x2 e; e.x = __builtin_amdgcn_exp2f(s.x); e.y = __builtin_amdgcn_exp2f(s.y);
    const f32x2 m = v * (q * e), r = v - m;
    f32x2 o; o.x = v.x < 0.f ? m.x : r.x; o.y = v.y < 0.f ? m.y : r.y; return o;
}
template <class Epi, class Sched, bool ALIGN_EPI = false, bool SP2 = false>
__device__ __forceinline__ void gemm_phase(PG8_LAS unsigned char* lds, const Gemm g, const Sched& S, const Epi& E, int wid) {
    int lane; asm volatile("v_mbcnt_lo_u32_b32 %0, -1, 0\n\tv_mbcnt_hi_u32_b32 %0, -1, %0" : "=v"(lane));
    const int tid = wid * 64 + lane, wr = wid >> 2, wc = wid & 3, fr = lane & 15, fq = lane >> 4;
    const int K = g.K, nt = K / BK;
    unsigned voffA[2], voffB[2];
#pragma unroll
    for (int i = 0; i < 2; ++i) { int R, C; stage_rc(tid * 16 + i * 8192, R, C); const int Rb = Epi::PERM ? ((R & ~31) + perm32(R & 31)) : R;
        voffA[i] = (unsigned)(R * K + C) * 2u; voffB[i] = (unsigned)(Rb * K + C) * 2u; }
    const size_t kstep = (size_t)(BK * 2);
    const size_t hstep = (size_t)HALF * K * 2;
    const size_t tstep = 2 * hstep;
    const unsigned ldsw = (unsigned)wid * 1024u;
    const int aoff = lds_byte(wr * 64 + fr, fq * 8), boff = lds_byte(wc * 32 + fr, fq * 8);
#define PG8_SA(b, h) (((b) * 2 + (h)) * HTB)
#define PG8_SB(b, h) ((4 + (b) * 2 + (h)) * HTB)
#define PG8_STAGE(bufoff, gbase, voff) do { _Pragma("unroll") for (int _i = 0; _i < 2; ++_i) \
        __builtin_amdgcn_global_load_lds((const unsigned*)((const char*)(gbase) + (voff)[_i]), (PG8_LAS unsigned*)(lds + (bufoff) + ldsw + _i * 8192), 16, 0, 0); } while (0)
#define PG8_LDA(dst, b, h) do { _Pragma("unroll") for (int m = 0; m < 4; ++m) _Pragma("unroll") for (int k = 0; k < 2; ++k) dst[m][k] = *(const PG8_LAS bf16x8*)(lds + PG8_SA(b, h) + aoff + m * 2048 + k * 1024); } while (0)
#define PG8_LDB(dst, b, h) do { _Pragma("unroll") for (int n = 0; n < 2; ++n) _Pragma("unroll") for (int k = 0; k < 2; ++k) dst[n][k] = *(const PG8_LAS bf16x8*)(lds + PG8_SB(b, h) + boff + n * 2048 + k * 1024); } while (0)
#define PG8_MMA(ai, bj, At, Bt) do { __builtin_amdgcn_s_setprio(1); _Pragma("unroll") for (int m = 0; m < 4; ++m) _Pragma("unroll") for (int n = 0; n < 2; ++n) _Pragma("unroll") for (int k = 0; k < 2; ++k) \
        acc[ai][bj][m][n] = __builtin_amdgcn_mfma_f32_16x16x32_bf16(Bt[n][k], At[m][k], acc[ai][bj][m][n], 0, 0, 0); __builtin_amdgcn_s_setprio(0); } while (0)
#define PG8_WAIT_V(n) asm volatile("s_waitcnt vmcnt(" #n ")" ::: "memory")
#define PG8_WAIT_L(n) asm volatile("s_waitcnt lgkmcnt(" #n ")" ::: "memory")
#define PG8_BAR __builtin_amdgcn_s_barrier()
#define PG8_SCHED __builtin_amdgcn_sched_barrier(0)
    Unit cur, nxt; int ui = 0;
    if (!S.next(0, cur)) return;
    f32x4 acc[2][2][4][2];
#pragma unroll
    for (int a = 0; a < 2; ++a)
#pragma unroll
        for (int b = 0; b < 2; ++b)
#pragma unroll
            for (int m = 0; m < 4; ++m)
#pragma unroll
                for (int n = 0; n < 2; ++n) acc[a][b][m][n] = (f32x4){0.f, 0.f, 0.f, 0.f};
    bf16x8 At[4][2], B0[2][2], B1[2][2];
    const char* cA = (const char*)g.A + (size_t)cur.pm * tstep; const char* cB = (const char*)g.Bt + (size_t)cur.pn * tstep;
    S.a_ready(cur);
    if constexpr (SP2) {
        PG8_STAGE(PG8_SB(0, 0), cB, voffB); PG8_STAGE(PG8_SB(0, 1), cB + hstep, voffB); PG8_STAGE(PG8_SA(0, 0), cA, voffA); PG8_STAGE(PG8_SA(0, 1), cA + hstep, voffA);
        if (wr == 1) PG8_BAR;
        PG8_WAIT_V(2); PG8_BAR;
        PG8_STAGE(PG8_SB(1, 0), cB + kstep, voffB); PG8_STAGE(PG8_SA(1, 0), cA + kstep, voffA); PG8_STAGE(PG8_SB(1, 1), cB + hstep + kstep, voffB);
        PG8_WAIT_V(6); PG8_BAR;
    } else {
        PG8_STAGE(PG8_SB(0, 0), cB, voffB); PG8_STAGE(PG8_SA(0, 0), cA, voffA); PG8_STAGE(PG8_SB(0, 1), cB + hstep, voffB); PG8_STAGE(PG8_SA(0, 1), cA + hstep, voffA);
        if (wr == 1) PG8_BAR;
        PG8_WAIT_V(4); PG8_BAR;
        PG8_STAGE(PG8_SB(1, 0), cB + kstep, voffB); PG8_STAGE(PG8_SA(1, 0), cA + kstep, voffA); PG8_STAGE(PG8_SB(1, 1), cB + hstep + kstep, voffB);
        PG8_WAIT_V(6); PG8_BAR;
    }
    for (;;) {
        const bool has_next = S.next(ui + 1, nxt);
        const char* nA = has_next ? (const char*)g.A + (size_t)nxt.pm * tstep : cA; const char* nB = has_next ? (const char*)g.Bt + (size_t)nxt.pn * tstep : cB;
        for (int t = 0; t < nt; t += 2) {
            const bool last = (t == nt - 2);
            const char* a1 = cA + (size_t)(t + 1) * kstep;
            const char* a2 = last ? nA : cA + (size_t)(t + 2) * kstep; const char* b2 = last ? nB : cB + (size_t)(t + 2) * kstep;
            const char* a3 = a2 + kstep; const char* b3 = b2 + kstep;
            if (last && has_next) S.a_ready(nxt);
            if constexpr (Epi::MIDK) { if (t == nt / 2) E.midk(acc, cur, wr, wc, fr, fq); }
            if constexpr (SP2) {
            PG8_LDB(B0, 0, 0); PG8_LDB(B1, 0, 1); PG8_SCHED; PG8_LDA(At, 0, 0); PG8_STAGE(PG8_SA(1, 1), a1 + hstep, voffA);
            PG8_WAIT_V(8); PG8_WAIT_L(0); PG8_BAR; PG8_MMA(0, 0, At, B0); PG8_MMA(0, 1, At, B1); PG8_BAR; PG8_SCHED;
            PG8_LDA(At, 0, 1); PG8_STAGE(PG8_SB(0, 0), b2, voffB); PG8_STAGE(PG8_SB(0, 1), b2 + hstep, voffB); PG8_STAGE(PG8_SA(0, 0), a2, voffA);
            PG8_WAIT_V(8); PG8_WAIT_L(0); PG8_BAR; PG8_MMA(1, 0, At, B0); PG8_MMA(1, 1, At, B1); PG8_BAR; PG8_SCHED;
            PG8_LDB(B0, 1, 0); PG8_LDB(B1, 1, 1); PG8_SCHED; PG8_LDA(At, 1, 0); PG8_STAGE(PG8_SA(0, 1), a2 + hstep, voffA);
            PG8_WAIT_V(8); PG8_WAIT_L(0); PG8_BAR; PG8_MMA(0, 0, At, B0); PG8_MMA(0, 1, At, B1); PG8_BAR; PG8_SCHED;
            PG8_LDA(At, 1, 1); PG8_STAGE(PG8_SB(1, 0), b3, voffB); PG8_STAGE(PG8_SB(1, 1), b3 + hstep, voffB); PG8_STAGE(PG8_SA(1, 0), a3, voffA);
            PG8_WAIT_V(8); PG8_WAIT_L(0); PG8_BAR; PG8_MMA(1, 0, At, B0); PG8_MMA(1, 1, At, B1); PG8_BAR; PG8_SCHED;
            } else {
            PG8_LDB(B0, 0, 0); PG8_SCHED; PG8_LDA(At, 0, 0); PG8_STAGE(PG8_SA(1, 1), a1 + hstep, voffA);
            PG8_WAIT_L(8); PG8_BAR; PG8_WAIT_L(0); PG8_MMA(0, 0, At, B0); PG8_BAR; PG8_SCHED;
            PG8_LDB(B1, 0, 1); PG8_STAGE(PG8_SB(0, 0), b2, voffB);
            PG8_BAR; PG8_WAIT_L(0); PG8_MMA(0, 1, At, B1); PG8_BAR;
            PG8_LDA(At, 0, 1); PG8_STAGE(PG8_SA(0, 0), a2, voffA);
            PG8_BAR; PG8_WAIT_L(0); PG8_MMA(1, 0, At, B0); PG8_BAR; PG8_SCHED;
            PG8_STAGE(PG8_SB(0, 1), b2 + hstep, voffB);
            PG8_WAIT_V(6); PG8_BAR; PG8_MMA(1, 1, At, B1); PG8_BAR;
            PG8_LDB(B0, 1, 0); PG8_SCHED; PG8_LDA(At, 1, 0); PG8_STAGE(PG8_SA(0, 1), a2 + hstep, voffA);
            PG8_WAIT_L(8); PG8_BAR; PG8_WAIT_L(0); PG8_MMA(0, 0, At, B0); PG8_BAR; PG8_SCHED;
            PG8_LDB(B1, 1, 1); PG8_STAGE(PG8_SB(1, 0), b3, voffB);
            PG8_BAR; PG8_WAIT_L(0); PG8_MMA(0, 1, At, B1); PG8_BAR;
            PG8_LDA(At, 1, 1); PG8_STAGE(PG8_SA(1, 0), a3, voffA);
            PG8_BAR; PG8_WAIT_L(0); PG8_MMA(1, 0, At, B0); PG8_BAR; PG8_SCHED;
            PG8_STAGE(PG8_SB(1, 1), b3 + hstep, voffB);
            PG8_WAIT_V(6); PG8_BAR; PG8_MMA(1, 1, At, B1); PG8_BAR;
            }
        }
        if constexpr (ALIGN_EPI) { if (wr == 0) PG8_BAR; }
        if constexpr (!Epi::AFTER_DRAIN) { E(acc, cur, wr, wc, fr, fq); S.done(cur); }
        if (!has_next) break;
#pragma unroll
        for (int a = 0; a < 2; ++a)
#pragma unroll
            for (int b = 0; b < 2; ++b)
#pragma unroll
                for (int m = 0; m < 4; ++m)
#pragma unroll
                    for (int n = 0; n < 2; ++n) acc[a][b][m][n] = (f32x4){0.f, 0.f, 0.f, 0.f};
        cur = nxt; cA = nA; cB = nB; ++ui;
        if constexpr (ALIGN_EPI) { if (wr == 1) PG8_BAR; }
    }
    PG8_WAIT_V(0);
    if constexpr (!ALIGN_EPI) { if (wr == 0) PG8_BAR; }
    PG8_BAR;
    if constexpr (Epi::AFTER_DRAIN) { E.fused(acc, cur, wr, wc, fr, fq, lds, wid, lane); S.done(cur); }
#undef PG8_SA
#undef PG8_SB
#undef PG8_STAGE
#undef PG8_LDA
#undef PG8_LDB
#undef PG8_MMA
#undef PG8_WAIT_V
#undef PG8_WAIT_L
#undef PG8_BAR
#undef PG8_SCHED
}
}
#define XB_TMO      128
#define XB_XCNT(j)  (256  + 64 * (j))
#define XB_XSUB(j)  (1280 + 64 * (j))
#define XB_XGEN(j)  (2304 + 64 * (j))
#define XB_TOP      3328
#define XB_TOPGEN   3392
#define XCD_BAR_WORDS 3456
#define XB_SPIN_CAP (1u << 18)
#define LAS __attribute__((address_space(3)))

__device__ __forceinline__ unsigned xb_ld(unsigned* p)              { return __hip_atomic_load(p, __ATOMIC_RELAXED, __HIP_MEMORY_SCOPE_AGENT); }
__device__ __forceinline__ unsigned xb_add(unsigned* p, unsigned v) { return __hip_atomic_fetch_add(p, v, __ATOMIC_RELAXED, __HIP_MEMORY_SCOPE_AGENT); }
__device__ __forceinline__ unsigned xb_xcc_id() { return (unsigned)__builtin_amdgcn_s_getreg((3 << 11) | 20) & 0xFu; }
#define XB_SPIN(cond, bar) do { unsigned _sp = 0; while (cond) { __builtin_amdgcn_s_sleep(1); \
    if ((++_sp & 255u) == 0u) { if (xb_ld(&(bar)[XB_TMO])) break; if (_sp > XB_SPIN_CAP) { atomicAdd(&(bar)[XB_TMO], 1u); break; } } } } while (0)

__device__ __forceinline__ bool xb_lane0() { int l; asm volatile("v_mbcnt_lo_u32_b32 %0, -1, 0\n\tv_mbcnt_hi_u32_b32 %0, -1, %0" : "=v"(l)); return l == 0; }
struct XcdBarrier {
    unsigned w;
    unsigned* bar; unsigned x;
    volatile LAS unsigned* st;
};

__device__ __forceinline__ XcdBarrier xcd_barrier_post(unsigned* bar, volatile LAS unsigned* st) {
    XcdBarrier b; b.bar = bar; b.x = xb_xcc_id(); b.st = st; b.w = (unsigned)__builtin_amdgcn_readfirstlane(threadIdx.x >> 6);
    if (b.w == 0u && xb_lane0()) (void)xb_add(&bar[XB_XCNT(b.x)], 1u);
    return b;
}
__device__ __forceinline__ void xcd_barrier_complete(unsigned* bar, unsigned x, unsigned& nloc, unsigned& nx) {
    const unsigned G = gridDim.x * gridDim.y * gridDim.z;
    unsigned sum, cnt, mine, sp = 0u;
    for (;;) {
        sum = 0u; cnt = 0u; mine = 0u;
#pragma unroll
        for (unsigned j = 0; j < 16; ++j) { const unsigned c = xb_ld(&bar[XB_XCNT(j)]); sum += c; cnt += (c > 0u) ? 1u : 0u; mine = (j == x) ? c : mine; }
        if (sum == G) break;
        __builtin_amdgcn_s_sleep(1);
        if ((++sp & 255u) == 0u) { if (xb_ld(&bar[XB_TMO])) break; if (sp > XB_SPIN_CAP) { atomicAdd(&bar[XB_TMO], 1u); break; } }
    }
    nloc = mine > 0u ? mine : 1u; nx = cnt > 0u ? cnt : 1u;
}

__device__ __forceinline__ void xcd_barrier(const XcdBarrier& b) {
    asm volatile("s_waitcnt vmcnt(0)" ::: "memory");
    __syncthreads();
    if (b.w == 0u && xb_lane0()) {
        unsigned* bar = b.bar;
        __builtin_amdgcn_s_waitcnt(0);
        unsigned nloc = b.st[0], nx = b.st[1];
        if (nloc == 0u) { xcd_barrier_complete(bar, b.x, nloc, nx); b.st[0] = nloc; b.st[1] = nx; }
        const unsigned old = xb_add(&bar[XB_XSUB(b.x)], 1u);
        const unsigned gen = old / nloc;
        if (old + 1u == (gen + 1u) * nloc) {
            __builtin_amdgcn_fence(__ATOMIC_RELEASE, "agent");
            asm volatile("s_waitcnt vmcnt(0)" ::: "memory");
            const unsigned og = xb_add(&bar[XB_TOP], 1u);
            const unsigned tg = og / nx;
            if (og + 1u == (tg + 1u) * nx) xb_add(&bar[XB_TOPGEN], 1u);
            else XB_SPIN(xb_ld(&bar[XB_TOPGEN]) == tg, bar);
            __builtin_amdgcn_fence(__ATOMIC_ACQUIRE, "agent");
            xb_add(&bar[XB_XGEN(b.x)], 1u);
            asm volatile("s_waitcnt vmcnt(0)" ::: "memory");
        } else {
            XB_SPIN(xb_ld(&bar[XB_XGEN(b.x)]) == gen, bar);
            __builtin_amdgcn_fence(__ATOMIC_ACQUIRE, "agent");
            asm volatile("s_waitcnt vmcnt(0)" ::: "memory");
        }
    }
    __syncthreads();
}
namespace mk {
using pg8::bf16x8; using pg8::f32x4; using pg8::u32x4; using pg8::bf16_t; using pg8::f32x2; using pg8::gelu_pk;
typedef float f32x16 __attribute__((ext_vector_type(16)));
typedef float f32x8 __attribute__((ext_vector_type(8)));
typedef short s16x4 __attribute__((ext_vector_type(4)));
typedef unsigned u32x2 __attribute__((ext_vector_type(2)));
typedef __bf16 nbf16x8 __attribute__((ext_vector_type(8)));
typedef __bf16 nbf16x4 __attribute__((ext_vector_type(4)));
typedef int i32x4 __attribute__((ext_vector_type(4)));

constexpr int NTOK = 8192, DM = 4096, SEQ = 2048, DIN = 10240, SW = 2048;
constexpr int NEXP = 64, DFF = 512;
constexpr float LN_EPS = 1e-5f;
constexpr float ALPHA = 1.189207115002721f;
constexpr float LOG2E = 1.4426950408889634f;
constexpr float QSCALE = 0.08838834764831845f * 1.4426950408889634f;
constexpr float NEG_BIG = -1e30f;
constexpr float LAMBDA_INIT = 0.2f;

constexpr size_t MiB = 1u << 20;
constexpr size_t WS_CTL = 0, CTL_ZERO_BYTES = 1 * MiB;
constexpr size_t WS_XB = 2 * MiB;
constexpr size_t WS_WINT = WS_XB + 64 * MiB;
constexpr size_t WS_WOUTT = WS_WINT + 80 * MiB;
constexpr size_t WS_WRT = WS_WOUTT + 32 * MiB;
constexpr size_t WS_QKVUG = WS_WRT + 2 * MiB;
constexpr size_t WS_GSTAT = WS_QKVUG + 160 * MiB;
constexpr size_t WS_AO = WS_GSTAT + 2 * MiB;
constexpr size_t WS_Y = WS_AO + 64 * MiB;
constexpr size_t WS_X1B = WS_Y + 128 * MiB;
constexpr size_t WS_ROUTE = WS_X1B + 64 * MiB;
constexpr size_t WS_TOKL = WS_ROUTE + 1 * MiB;
constexpr size_t WS_WL = WS_TOKL + 2 * MiB;
constexpr size_t WS_H = WS_WL + 2 * MiB;
constexpr size_t WS_YS = WS_H + 16 * MiB;
constexpr float YS_SCALE = 64.0f;
constexpr size_t WS_YSTAT = WS_YS + 128 * MiB;
constexpr size_t WS_GPART = WS_YSTAT + 4 * MiB;
constexpr size_t WS_END = WS_GPART + 1 * MiB;
constexpr int CW_CNT = 4096;
constexpr int CW_BAR = 8192;
constexpr int LDS_BYTES = 163840;
constexpr int MISC_OFF = LDS_BYTES - 256;

__device__ __forceinline__ float bf2f(unsigned short b) { return __uint_as_float(((unsigned)b) << 16); }
__device__ __forceinline__ unsigned f2bf(float f) { unsigned u = __float_as_uint(f); return (u + 0x7fffu + ((u >> 16) & 1u)) >> 16; }
__device__ __forceinline__ unsigned pk2(float lo, float hi) { return f2bf(lo) | (f2bf(hi) << 16); }
__device__ __forceinline__ bf16x8 cvt8(f32x8 v) { return __builtin_bit_cast(bf16x8, __builtin_convertvector(v, nbf16x8)); }
__device__ __forceinline__ s16x4 cvt4(f32x4 v) { return __builtin_bit_cast(s16x4, __builtin_convertvector(v, nbf16x4)); }
__device__ __forceinline__ float wave_sum(float v) {
#pragma unroll
    for (int o = 1; o < 64; o <<= 1) v += __shfl_xor(v, o);
    return v;
}
#define MFMA32(a, b, c) __builtin_amdgcn_mfma_f32_32x32x16_bf16((a), (b), (c), 0, 0, 0)
#define MFMA16(a, b, c) __builtin_amdgcn_mfma_f32_16x16x32_bf16((a), (b), (c), 0, 0, 0)

template <bool SCALE>
__device__ __forceinline__ void p0_transpose_item(const float* W, int K, int N, bf16_t* WT, LAS float* scr, int item, int lane,
                                                  const float* subln_g, const float* beta_attn, const float* beta_gmlp) {
    const int nblk = N / 64, kb = item / nblk, nb = item % nblk, k0 = 64 * kb, n0 = 64 * nb;
#pragma unroll
    for (int hb = 0; hb < 2; ++hb) {
        float v[32];
#pragma unroll
        for (int i = 0; i < 32; ++i) v[i] = __builtin_nontemporal_load(W + (size_t)(k0 + 32 * hb + i) * N + n0 + lane);
#pragma unroll
        for (int i = 0; i < 32; ++i) {
            const int kk = 32 * hb + i; float t = v[i];
            if (SCALE) { const int k = k0 + kk; const float sc = (k < SW) ? subln_g[k & 255] * (1.0f - LAMBDA_INIT) * beta_attn[k] : beta_gmlp[k - SW]; t *= sc; }
            scr[kk * 65 + lane] = t; }
    }
    asm volatile("s_waitcnt lgkmcnt(0)" ::: "memory");
    const int c = lane & 7;
#pragma unroll
    for (int j = 0; j < 8; ++j) { const int n = (lane >> 3) + 8 * j; const LAS float* s = scr + (8 * c) * 65 + n;
        u32x4 o; o.x = pk2(s[0 * 65], s[1 * 65]); o.y = pk2(s[2 * 65], s[3 * 65]); o.z = pk2(s[4 * 65], s[5 * 65]); o.w = pk2(s[6 * 65], s[7 * 65]);
        *(u32x4*)(WT + (size_t)(n0 + n) * K + (SCALE ? ((k0 + SW) & (DM - 1)) : k0) + 8 * c) = o; }
    asm volatile("s_waitcnt lgkmcnt(0)" ::: "memory");
}

__device__ __forceinline__ void p0_prologue(LAS unsigned char* lds, const float* const* in, unsigned char* ws, int vcu, int G, int tid, int wid, int lane) {
    const float* x = in[0]; const float* w_in = in[1]; const float* w_out = in[2];
    bf16_t* XB = (bf16_t*)(ws + WS_XB); bf16_t* WINT = (bf16_t*)(ws + WS_WINT); bf16_t* WOUTT = (bf16_t*)(ws + WS_WOUTT); bf16_t* WRT = (bf16_t*)(ws + WS_WRT);
    { const size_t nch = (size_t)NTOK * DM / 8, nthr = (size_t)G * 512; const f32x4* xi = (const f32x4*)x; u32x4* xo = (u32x4*)XB;
      for (size_t i = (size_t)vcu * 512 + tid; i < nch; i += 4 * nthr) {
          f32x4 a[4], b[4];
#pragma unroll
          for (int q = 0; q < 4; ++q) { const size_t c = (i + q * nthr) < nch ? (i + q * nthr) : i; a[q] = __builtin_nontemporal_load(xi + 2 * c); b[q] = __builtin_nontemporal_load(xi + 2 * c + 1); }
#pragma unroll
          for (int q = 0; q < 4; ++q) { f32x8 v = {a[q][0], a[q][1], a[q][2], a[q][3], b[q][0], b[q][1], b[q][2], b[q][3]}; if (i + q * nthr < nch) xo[i + q * nthr] = __builtin_bit_cast(u32x4, cvt8(v)); } } }
    LAS float* scr = (LAS float*)(lds + wid * 16896);
    const int gw = vcu * 8 + wid, NGW = G * 8;
    constexpr int I_IN = (DM / 64) * (DIN / 64), I_OUT = (DM / 64) * (DM / 64);
    for (int it = gw; it < I_IN + I_OUT; it += NGW) {
        if (it < I_IN) p0_transpose_item<false>(w_in, DM, DIN, WINT, scr, it, lane, nullptr, nullptr, nullptr);
        else p0_transpose_item<true>(w_out, DM, DM, WOUTT, scr, it - I_IN, lane, in[7], in[8], in[13]);
    }
    { const float* wg = in[17]; const float* we = in[19];
      for (int i = vcu * 512 + tid; i < 80 * DM; i += G * 512) { const int j = i / DM, c = i % DM;
          const float v = j < 8 ? wg[c * 8 + j] : (j < 72 ? we[c * 64 + (j - 8)] : 0.f);
          const unsigned hi = f2bf(v); const float r = v - __uint_as_float(hi << 16);
          WRT[i] = (bf16_t)hi; WRT[80 * DM + i] = (bf16_t)f2bf(r); } }
}

struct EpiProj {
    static constexpr bool PERM = true, AFTER_DRAIN = false, MIDK = false;
    bf16_t* base; float* gstat;
    __device__ __forceinline__ void operator()(const f32x4 (&acc)[2][2][4][2], const pg8::Unit& u, int wr, int wc, int fr, int fq) const {
        const int sect = u.pn >> 3, colt = (u.pn & 7) * 256;
        bf16_t* O = base + (size_t)sect * ((size_t)NTOK * SW);
        const int row0 = u.pm * 256 + wr * 64 + fr, col0 = colt + wc * 32 + 8 * fq;
#pragma unroll
        for (int ai = 0; ai < 2; ++ai)
#pragma unroll
            for (int m = 0; m < 4; ++m) {
                const int row = row0 + ai * 128 + m * 16;
                bf16_t* rowp = O + (size_t)row * SW + col0; float s1 = 0.f, s2 = 0.f;
#pragma unroll
                for (int bj = 0; bj < 2; ++bj) {
                    f32x4 v0 = acc[ai][bj][m][0], v1 = acc[ai][bj][m][1];
                    if (sect == 0) { v0 *= QSCALE; v1 *= QSCALE; }
                    if (sect >= 3) { f32x2 a = gelu_pk((f32x2){v0[0], v0[1]}), b = gelu_pk((f32x2){v0[2], v0[3]}), c = gelu_pk((f32x2){v1[0], v1[1]}), d = gelu_pk((f32x2){v1[2], v1[3]});
                        v0 = (f32x4){a.x, a.y, b.x, b.y}; v1 = (f32x4){c.x, c.y, d.x, d.y}; }
                    if (sect == 4) { s1 += (v0[0] + v0[1]) + (v0[2] + v0[3]) + (v1[0] + v1[1]) + (v1[2] + v1[3]);
                        s2 += (v0[0] * v0[0] + v0[1] * v0[1]) + (v0[2] * v0[2] + v0[3] * v0[3]) + (v1[0] * v1[0] + v1[1] * v1[1]) + (v1[2] * v1[2] + v1[3] * v1[3]); }
                    f32x8 v8 = {v0[0], v0[1], v0[2], v0[3], v1[0], v1[1], v1[2], v1[3]};
                    *(u32x4*)(rowp + bj * 128) = __builtin_bit_cast(u32x4, cvt8(v8));
                }
                if (sect == 4) { s1 += __shfl_xor(s1, 16); s1 += __shfl_xor(s1, 32); s2 += __shfl_xor(s2, 16); s2 += __shfl_xor(s2, 32);
                    if (fq == 0) *(f32x2*)(gstat + ((size_t)row * 32 + (u.pn & 7) * 4 + wc) * 2) = (f32x2){s1, s2}; }
            }
    }
};

struct EpiY {
    static constexpr bool PERM = true, AFTER_DRAIN = false, MIDK = true;
    const bf16_t* xb; bf16_t* Y; float* ystat; const float* gpart;
    __device__ __forceinline__ void midk(f32x4 (&acc)[2][2][4][2], const pg8::Unit& u, int wr, int wc, int fr, int fq) const {
        int fro = fr; asm volatile("" : "+v"(fro));
        const float* gp0 = gpart + (size_t)(u.pm * 256 + wr * 64 + fro) * 8;
#pragma unroll
        for (int ai = 0; ai < 2; ++ai)
#pragma unroll
            for (int m = 0; m < 4; ++m) { const float* gp = gp0 + (ai * 128 + m * 16) * 8; const f32x4 a = *(const f32x4*)gp, b = *(const f32x4*)(gp + 4);
                const float rs = __builtin_amdgcn_rsqf(((a[0] + a[1]) + (a[2] + a[3]) + (b[0] + b[1]) + (b[2] + b[3])) * (1.0f / SW) + LN_EPS);
#pragma unroll
                for (int bj = 0; bj < 2; ++bj)
#pragma unroll
                    for (int n = 0; n < 2; ++n) acc[ai][bj][m][n] *= rs;
                asm volatile("" ::: "memory"); }
    }
    __device__ __forceinline__ void operator()(const f32x4 (&acc)[2][2][4][2], const pg8::Unit& u, int wr, int wc, int fr, int fq) const {
        const int row0 = u.pm * 256 + wr * 64 + fr, col0 = u.pn * 256 + wc * 32 + 8 * fq;
#pragma unroll
        for (int ai = 0; ai < 2; ++ai)
#pragma unroll
            for (int m = 0; m < 4; ++m) { const int row = row0 + ai * 128 + m * 16; const size_t off = (size_t)row * DM + col0; float s1 = 0.f, s2 = 0.f;
#pragma unroll
                for (int bj = 0; bj < 2; ++bj) { const u32x4 xr = *(const u32x4*)(xb + off + bj * 128);
                    f32x8 y;
                    y[0] = ALPHA * __uint_as_float(xr.x << 16) + acc[ai][bj][m][0][0]; y[1] = ALPHA * __uint_as_float(xr.x & 0xffff0000u) + acc[ai][bj][m][0][1];
                    y[2] = ALPHA * __uint_as_float(xr.y << 16) + acc[ai][bj][m][0][2]; y[3] = ALPHA * __uint_as_float(xr.y & 0xffff0000u) + acc[ai][bj][m][0][3];
                    y[4] = ALPHA * __uint_as_float(xr.z << 16) + acc[ai][bj][m][1][0]; y[5] = ALPHA * __uint_as_float(xr.z & 0xffff0000u) + acc[ai][bj][m][1][1];
                    y[6] = ALPHA * __uint_as_float(xr.w << 16) + acc[ai][bj][m][1][2]; y[7] = ALPHA * __uint_as_float(xr.w & 0xffff0000u) + acc[ai][bj][m][1][3];
                    *(u32x4*)(Y + off + bj * 128) = __builtin_bit_cast(u32x4, cvt8(y));
#pragma unroll
                    for (int j = 0; j < 8; ++j) { s1 += y[j]; s2 += y[j] * y[j]; } }
                s1 += __shfl_xor(s1, 16); s1 += __shfl_xor(s1, 32); s2 += __shfl_xor(s2, 16); s2 += __shfl_xor(s2, 32);
                if (fq == 0) *(f32x2*)(ystat + ((size_t)row * 64 + u.pn * 4 + wc) * 2) = (f32x2){s1, s2};
                asm volatile("" ::: "memory"); }
    }
};
constexpr int AT_STAGE = 65536, AT_K1 = 16384, AT_V = 32768, AT_TAB = 143360  , AT_XSTRIDE = 260;

__device__ __forceinline__ void attn_dma_offsets(unsigned (&ko)[2], unsigned (&vo)[2], int wid, int lane) {
#pragma unroll
    for (int j = 0; j < 2; ++j) { const int i = wid * 2 + j, row = 4 * i + (lane >> 4), gch = (lane & 15) ^ (row & 15);
        ko[j] = (unsigned)((row * SW + 8 * gch) * 2); }
#pragma unroll
    for (int j = 0; j < 2; ++j) { const int i = wid * 4 + j, row = 2 * i + (lane >> 5), gch = (lane & 31) ^ ((row & 3) << 2);
        vo[j] = (unsigned)((row * SW + 8 * gch) * 2); }
}
__device__ __forceinline__ void attn_issue_tile(LAS unsigned char* stage, __amdgpu_buffer_rsrc_t krs, __amdgpu_buffer_rsrc_t vrs, int soff, const unsigned (&ko)[2], const unsigned (&vo)[2], int wid) {
#pragma unroll
    for (int j = 0; j < 2; ++j) {
        __builtin_amdgcn_raw_ptr_buffer_load_lds(krs, (LAS unsigned*)(stage + (wid * 2 + j) * 1024), 16, ko[j], soff, 0, 0);
        __builtin_amdgcn_raw_ptr_buffer_load_lds(krs, (LAS unsigned*)(stage + AT_K1 + (wid * 2 + j) * 1024), 16, ko[j], soff + 256, 0, 0);
    }
#pragma unroll
    for (int j = 0; j < 4; ++j)
        __builtin_amdgcn_raw_ptr_buffer_load_lds(vrs, (LAS unsigned*)(stage + AT_V + (wid * 4 + j) * 1024), 16, vo[j & 1], soff + (j >> 1) * (4 * SW * 2), 0, 0);
}

__device__ __forceinline__ int crow(int reg, int h) { return (reg & 3) + 8 * (reg >> 2) + 4 * h; }
constexpr float AT_THR = 8.0f;

__device__ __forceinline__ void attn_unit(LAS unsigned char* lds, const bf16_t* Qb, const bf16_t* Kb, const bf16_t* Vb, bf16_t* AO,
                                          int b, int h, int qt, float lam, int tid, int wid, int lane_in) {
    int lane = lane_in; asm volatile("" : "+v"(lane));
    const int map = wid >> 2, wq = wid & 3, r = lane & 31, hh = lane >> 5;
    const int hcol = h * 256;
    const size_t seq0 = (size_t)b * SEQ;
    const int qpos = qt * 128 + wq * 32 + r;
    const LAS float* tab = (const LAS float*)(lds + AT_TAB) + 32;
    bf16x8 qf[8];
    { const bf16_t* qp = Qb + (seq0 + qpos) * SW + hcol + map * 128 + 8 * hh;
#pragma unroll
      for (int s = 0; s < 8; ++s) qf[s] = *(const bf16x8*)(qp + 16 * s); }
    const int ntiles = 2 * (qt + 1);
    f32x16 O[8];
#pragma unroll
    for (int c = 0; c < 8; ++c)
#pragma unroll
        for (int i = 0; i < 16; ++i) O[c][i] = 0.f;
    float m_run = NEG_BIG, l_run = 0.f;
    const float farb = tab[255];
    const int kx = r & 15;
    const int q4 = (lane & 15) >> 2, p4 = lane & 3, blk = (lane >> 4) & 1;
    int vb[4];
#pragma unroll
    for (int c1 = 0; c1 < 4; ++c1) vb[c1] = (4 * hh + q4) * 512 + 64 * (c1 ^ q4) + 32 * blk + 16 * (p4 >> 1) + 8 * (p4 & 1);
    unsigned ko[2], vo[2];
    attn_dma_offsets(ko, vo, wid, lane);
    const __amdgpu_buffer_rsrc_t krs = __builtin_amdgcn_make_buffer_rsrc((void*)Kb, 0, NTOK * SW * 2, 0x00020000);
    const __amdgpu_buffer_rsrc_t vrs = __builtin_amdgcn_make_buffer_rsrc((void*)Vb, 0, NTOK * SW * 2, 0x00020000);
    const int soff0 = (int)((seq0 * SW + hcol) * 2);
    constexpr int TILE_BYTES = 64 * SW * 2;

    attn_issue_tile(lds, krs, vrs, soff0, ko, vo, wid);
    asm volatile("s_waitcnt vmcnt(0)" ::: "memory");
    __syncthreads();
#pragma unroll 1
    for (int t = 0; t < ntiles; ++t) {
        LAS unsigned char* stage = lds + (t & 1) * AT_STAGE;
        if (t + 1 < ntiles) attn_issue_tile(lds + ((t + 1) & 1) * AT_STAGE, krs, vrs, soff0 + (t + 1) * TILE_BYTES, ko, vo, wid);
        const int kbase = 64 * t;
        const bool far = (qt * 128 + wq * 32 - (kbase + 63)) >= 128;
#pragma unroll
        for (int tt = 0; tt < 2; ++tt) {
            if (kbase + 32 * tt > qt * 128 + wq * 32 + 31) continue;
            const LAS unsigned char* kt = stage + map * AT_K1 + (32 * tt + r) * 256;
            f32x16 X;
#pragma unroll
            for (int i = 0; i < 16; ++i) X[i] = 0.f;
#pragma unroll
            for (int s = 0; s < 8; ++s) {
                const bf16x8 kf = *(const LAS bf16x8*)(kt + 16 * ((2 * s + hh) ^ kx));
                X = MFMA32(kf, qf[s], X);
            }
            if (far) {
#pragma unroll
                for (int i = 0; i < 16; ++i) X[i] += farb;
            } else {
                const LAS float* tp = tab + (qpos - (kbase + 32 * tt + 4 * hh));
#pragma unroll
                for (int i = 0; i < 16; ++i) X[i] += tp[-((i & 3) + 8 * (i >> 2))];
            }
            float mx = X[0];
#pragma unroll
            for (int i = 1; i < 16; ++i) mx = fmaxf(mx, X[i]);
            mx = fmaxf(mx, __shfl_xor(mx, 32));
            const bool upd = mx > m_run + AT_THR;
            if (__any(upd)) {
                const float mnew = upd ? mx : m_run;
                const float alpha = __builtin_amdgcn_exp2f(m_run - mnew);
                m_run = mnew; l_run *= alpha;
#pragma unroll
                for (int c = 0; c < 8; ++c)
#pragma unroll
                    for (int i = 0; i < 16; ++i) O[c][i] *= alpha;
            }
            float ls = 0.f;
#pragma unroll
            for (int i = 0; i < 16; ++i) { X[i] = __builtin_amdgcn_exp2f(X[i] - m_run); ls += X[i]; }
            l_run += ls;
            bf16x8 pf[2];
#pragma unroll
            for (int s = 0; s < 2; ++s) {
                f32x8 a;
#pragma unroll
                for (int j = 0; j < 8; ++j) a[j] = X[8 * s + j];
                pf[s] = cvt8(a);
            }
            const LAS unsigned char* vt = stage + AT_V + (32 * tt) * 512;
#pragma unroll
            for (int s = 0; s < 2; ++s)
#pragma unroll
                for (int c = 0; c < 8; ++c) {
                    const int rowoff = (16 * s) * 512 + 256 * (c >> 2);
                    const s16x4 lo = __builtin_amdgcn_ds_read_tr16_b64_v4i16((LAS s16x4*)(vt + vb[c & 3] + rowoff));
                    const s16x4 hi = __builtin_amdgcn_ds_read_tr16_b64_v4i16((LAS s16x4*)(vt + vb[c & 3] + rowoff + 8 * 512));
                    const bf16x8 vf = __builtin_shufflevector(lo, hi, 0, 1, 2, 3, 4, 5, 6, 7);
                    O[c] = MFMA32(vf, pf[s], O[c]);
                }
        }
        asm volatile("s_waitcnt vmcnt(0)" ::: "memory");
        __syncthreads();
    }
    const float ltot = l_run + __shfl_xor(l_run, 32);
    const float inv = 1.0f / ltot;
    int lane_e = lane_in; asm volatile("" : "+v"(lane_e));
    const int r_e = lane_e & 31, hh_e = lane_e >> 5;
    LAS float* xb = (LAS float*)lds + (size_t)wq * (32 * AT_XSTRIDE) + r_e * AT_XSTRIDE + 4 * hh_e;
    if (map == 1) {
        const float sc = inv * lam;
#pragma unroll
        for (int c = 0; c < 8; ++c)
#pragma unroll
            for (int g = 0; g < 4; ++g) {
                f32x4 v = {O[c][4 * g] * sc, O[c][4 * g + 1] * sc, O[c][4 * g + 2] * sc, O[c][4 * g + 3] * sc};
                *(LAS f32x4*)(xb + 32 * c + 8 * g) = v;
            }
    }
    __syncthreads();
    if (map == 0) {
        float ss = 0.f;
#pragma unroll
        for (int c = 0; c < 8; ++c)
#pragma unroll
            for (int g = 0; g < 4; ++g) {
                const f32x4 o1 = *(const LAS f32x4*)(xb + 32 * c + 8 * g);
#pragma unroll
                for (int j = 0; j < 4; ++j) { const float d = O[c][4 * g + j] * inv - o1[j]; O[c][4 * g + j] = d; ss += d * d; }
                if (g & 1) asm volatile("" ::: "memory");
            }
        ss += __shfl_xor(ss, 32);
        const float rs = __builtin_amdgcn_rsqf(ss * (1.0f / 256.0f) + LN_EPS);
        bf16_t* op = AO + (seq0 + qt * 128 + wq * 32 + r_e) * DM + SW + hcol + 4 * hh_e;
#pragma unroll
        for (int c = 0; c < 8; ++c)
#pragma unroll
            for (int g = 0; g < 4; ++g) {
                f32x4 v = {O[c][4 * g] * rs, O[c][4 * g + 1] * rs, O[c][4 * g + 2] * rs, O[c][4 * g + 3] * rs};
                *(s16x4*)(op + 32 * c + 8 * g) = cvt4(v);
            }
    }
    __syncthreads();
}

__device__ __forceinline__ void attn_phase(LAS unsigned char* lds, const float* const* in, unsigned char* ws, int vcu, int G, int tid, int wid, int lane) {
    const bf16_t* Qb = (const bf16_t*)(ws + WS_QKVUG); const bf16_t* Kb = Qb + (size_t)NTOK * SW; const bf16_t* Vb = Kb + (size_t)NTOK * SW;
    bf16_t* AO = (bf16_t*)(ws + WS_AO);
    float lam;
    { const float* q1 = in[3]; const float* k1 = in[4]; const float* q2 = in[5]; const float* k2 = in[6];
      float s1 = q1[lane] * k1[lane] + q1[lane + 64] * k1[lane + 64], s2 = q2[lane] * k2[lane] + q2[lane + 64] * k2[lane + 64];
      s1 = wave_sum(s1); s2 = wave_sum(s2); lam = __expf(s1) - __expf(s2) + LAMBDA_INIT; }
    const float* rel = in[14];
    int cur_h = -1;
    if (wid >= 4) __builtin_amdgcn_s_setprio(1);
    for (int p = vcu; p < 256; p += G) {
        const int bh = p >> 3, s = p & 7, b = bh >> 3, h = bh & 7;
        if (h != cur_h) {
            __syncthreads();
            int tid_o = tid; asm volatile("" : "+v"(tid_o));
            if (tid_o < 288) { const int n = tid_o - 32; int bucket;
                if (n < 16) bucket = n < 0 ? 0 : n; else { const int lg = 16 + (int)(logf((float)n * (1.0f / 16.0f)) / 2.0794415416798357f * 16.0f); bucket = lg < 31 ? lg : 31; }
                ((LAS float*)(lds + AT_TAB))[tid_o] = n < 0 ? NEG_BIG : rel[bucket * 8 + h] * LOG2E; }
            __syncthreads(); cur_h = h;
        }
        attn_unit(lds, Qb, Kb, Vb, AO, b, h, 15 - s, lam, tid, wid, lane);
        attn_unit(lds, Qb, Kb, Vb, AO, b, h, s, lam, tid, wid, lane);
    }
    __builtin_amdgcn_s_setprio(0);
}
constexpr int GM_STAT = 131072;
constexpr int GM_RED = 132096;
constexpr int GM_W = 65536;

__device__ __forceinline__ int gm_voff(int s, int c8) { return s * 512 + 16 * (c8 ^ (((s & 3) << 1) | (((s >> 3) & 1) << 3))); }

__device__ __forceinline__ void gmlp_unit(LAS unsigned char* lds, const float* const* in, unsigned char* ws, int b, int ch, int h, int tid_in, int wid, int lane_in) {
    int tid = tid_in; asm volatile("" : "+v"(tid)); const int lane = tid & 63;
    const bf16_t* U = (const bf16_t*)(ws + WS_QKVUG) + (size_t)3 * NTOK * SW; const bf16_t* GG = U + (size_t)NTOK * SW;
    const float* gstat = (const float*)(ws + WS_GSTAT);
    bf16_t* AO = (bf16_t*)(ws + WS_AO); float* gpart = (float*)(ws + WS_GPART);
    const float* ln_g = in[9]; const float* ln_b = in[10]; const float* spw = in[11]; const float* spb = in[12];
    const size_t R0 = (size_t)b * SEQ + (size_t)ch * 128;
    LAS float* st = (LAS float*)(lds + GM_STAT); LAS float* red = (LAS float*)(lds + GM_RED);
    __syncthreads();
    if (tid < 128) { const float* gp = gstat + (R0 + tid) * 64; float s1 = 0.f, s2 = 0.f;
#pragma unroll
        for (int p = 0; p < 32; ++p) { s1 += gp[2 * p]; s2 += gp[2 * p + 1]; }
        const float mean = s1 * (1.0f / SW), var = fmaxf(s2 * (1.0f / SW) - mean * mean, 0.f);
        st[2 * tid] = mean; st[2 * tid + 1] = __builtin_amdgcn_rsqf(var + LN_EPS); }
    __syncthreads();
    const int tl = lane & 15, g4 = lane >> 4, q4 = (lane & 15) >> 2, p4 = lane & 3;
#pragma unroll
    for (int i = 0; i < 8; ++i) {
        const int idx = tid + 512 * i, s = idx >> 5, c8 = idx & 31; const int col = h * 256 + 8 * c8;
        const u32x4 raw = *(const u32x4*)(GG + (R0 + s) * SW + col);
        const f32x4 ga = *(const f32x4*)(ln_g + col), gb = *(const f32x4*)(ln_g + col + 4), ba = *(const f32x4*)(ln_b + col), bb = *(const f32x4*)(ln_b + col + 4);
        const float mean = st[2 * s], rstd = st[2 * s + 1];
        f32x8 v;
        v[0] = (__uint_as_float(raw.x << 16) - mean) * rstd * ga[0] + ba[0]; v[1] = (__uint_as_float(raw.x & 0xffff0000u) - mean) * rstd * ga[1] + ba[1];
        v[2] = (__uint_as_float(raw.y << 16) - mean) * rstd * ga[2] + ba[2]; v[3] = (__uint_as_float(raw.y & 0xffff0000u) - mean) * rstd * ga[3] + ba[3];
        v[4] = (__uint_as_float(raw.z << 16) - mean) * rstd * gb[0] + bb[0]; v[5] = (__uint_as_float(raw.z & 0xffff0000u) - mean) * rstd * gb[1] + bb[1];
        v[6] = (__uint_as_float(raw.w << 16) - mean) * rstd * gb[2] + bb[2]; v[7] = (__uint_as_float(raw.w & 0xffff0000u) - mean) * rstd * gb[3] + bb[3];
        *(LAS bf16x8*)(lds + gm_voff(s, c8)) = cvt8(v);
    }
#pragma unroll
    for (int i = 0; i < 4; ++i) {
        const int idx = tid + 512 * i, t = idx >> 4, c = idx & 15;
        const float* wp = spw + ((size_t)h * 128 + t) * 128 + 8 * c;
        const f32x4 a = *(const f32x4*)wp, b4 = *(const f32x4*)(wp + 4);
        f32x8 w = {a[0], a[1], a[2], a[3], b4[0], b4[1], b4[2], b4[3]};
#pragma unroll
        for (int j = 0; j < 8; ++j) w[j] = (8 * c + j <= t) ? w[j] : 0.f;
        *(LAS bf16x8*)(lds + GM_W + t * 272 + 16 * c) = cvt8(w);
    }
    __syncthreads();
    f32x4 acc[8][2];
#pragma unroll
    for (int mt = 0; mt < 8; ++mt)
#pragma unroll
        for (int nl = 0; nl < 2; ++nl) acc[mt][nl] = (f32x4){0.f, 0.f, 0.f, 0.f};
    u32x2 ur[8][2]; float bsv[8];
#pragma unroll
    for (int mt = 0; mt < 8; ++mt) { const int t_in = 16 * mt + tl; bsv[mt] = spb[h * 128 + t_in];
#pragma unroll
        for (int nl = 0; nl < 2; ++nl) ur[mt][nl] = *(const u32x2*)(U + (R0 + t_in) * SW + h * 256 + 16 * (2 * wid + nl) + 4 * g4); }
#pragma unroll
    for (int ks = 0; ks < 4; ++ks) {
        bf16x8 vf[2];
#pragma unroll
        for (int nl = 0; nl < 2; ++nl) {
            const int c = 2 * wid + nl, r0 = 32 * ks + 8 * g4 + q4;
            const s16x4 lo = __builtin_amdgcn_ds_read_tr16_b64_v4i16((LAS s16x4*)(lds + gm_voff(r0, 2 * c + (p4 >> 1)) + 8 * (p4 & 1)));
            const s16x4 hi = __builtin_amdgcn_ds_read_tr16_b64_v4i16((LAS s16x4*)(lds + gm_voff(r0 + 4, 2 * c + (p4 >> 1)) + 8 * (p4 & 1)));
            vf[nl] = __builtin_shufflevector(lo, hi, 0, 1, 2, 3, 4, 5, 6, 7);
        }
#pragma unroll
        for (int mt = 2 * ks; mt < 8; ++mt) {
            const bf16x8 wf = *(const LAS bf16x8*)(lds + GM_W + (16 * mt + tl) * 272 + (32 * ks + 8 * g4) * 2);
#pragma unroll
            for (int nl = 0; nl < 2; ++nl) acc[mt][nl] = MFMA16(vf[nl], wf, acc[mt][nl]);
        }
    }
#pragma unroll
    for (int mt = 0; mt < 8; ++mt) {
        const int t_in = 16 * mt + tl; const float bs = bsv[mt]; float ssq = 0.f;
#pragma unroll
        for (int nl = 0; nl < 2; ++nl) {
            const int col = h * 256 + 16 * (2 * wid + nl) + 4 * g4;
            const u32x2 uq = ur[mt][nl];
            f32x4 g;
            g[0] = __uint_as_float(uq.x << 16) * (acc[mt][nl][0] + bs); g[1] = __uint_as_float(uq.x & 0xffff0000u) * (acc[mt][nl][1] + bs);
            g[2] = __uint_as_float(uq.y << 16) * (acc[mt][nl][2] + bs); g[3] = __uint_as_float(uq.y & 0xffff0000u) * (acc[mt][nl][3] + bs);
            ssq += (g[0] * g[0] + g[1] * g[1]) + (g[2] * g[2] + g[3] * g[3]);
            *(s16x4*)(AO + (R0 + t_in) * DM + col) = cvt4(g);
        }
        ssq += __shfl_xor(ssq, 16); ssq += __shfl_xor(ssq, 32);
        if (g4 == 0) red[wid * 128 + t_in] = ssq;
    }
    __syncthreads();
    if (tid < 128) { float tot = 0.f;
#pragma unroll
        for (int w = 0; w < 8; ++w) tot += red[w * 128 + tid];
        gpart[(R0 + tid) * 8 + h] = tot; }
}

__device__ __forceinline__ void gmlp_phase(LAS unsigned char* lds, const float* const* in, unsigned char* ws, int vcu, int G, int tid, int wid, int lane) {
    for (int u = vcu; u < 512; u += G) gmlp_unit(lds, in, ws, u >> 7, (u >> 3) & 15, u & 7, tid, wid, lane);
}
constexpr int RT_STAT = 0;
constexpr int RT_PART = 1024;
constexpr int RT_LOGIT = 1024 + 8 * 32 * 80 * 4;

__device__ __forceinline__ void route_unit(LAS unsigned char* lds, const float* const* in, float* zout, unsigned char* ws, int rgp, int tid, int wid, int lane) {
    const bf16_t* Y = (const bf16_t*)(ws + WS_Y); bf16_t* X1B = (bf16_t*)(ws + WS_X1B);
    const bf16_t* WRT = (const bf16_t*)(ws + WS_WRT);
    const float* g1 = in[15]; const float* b1 = in[16];
    LAS float* st = (LAS float*)(lds + RT_STAT); LAS float* part = (LAS float*)(lds + RT_PART); LAS float* logit = (LAS float*)(lds + RT_LOGIT);
    const int row0 = rgp * 32;
    __syncthreads();
    { const float* ystat = (const float*)(ws + WS_YSTAT); const int r = tid >> 4, sub = tid & 15;
      const f32x4* yp = (const f32x4*)(ystat + ((size_t)(row0 + r) * 64 + sub * 4) * 2);
      const f32x4 a = yp[0], b = yp[1];
      float s1 = (a[0] + a[2]) + (b[0] + b[2]), s2 = (a[1] + a[3]) + (b[1] + b[3]);
#pragma unroll
      for (int o = 1; o < 16; o <<= 1) { s1 += __shfl_xor(s1, o); s2 += __shfl_xor(s2, o); }
      if (sub == 0) { const float mean = s1 * (1.0f / DM), var = fmaxf(s2 * (1.0f / DM) - mean * mean, 0.f); st[2 * r] = mean; st[2 * r + 1] = __builtin_amdgcn_rsqf(var + LN_EPS); } }
    __syncthreads();
    const int tl = lane & 15, g4 = lane >> 4;
    f32x4 acc[2][5];
#pragma unroll
    for (int mt = 0; mt < 2; ++mt)
#pragma unroll
        for (int nt = 0; nt < 5; ++nt) acc[mt][nt] = (f32x4){0.f, 0.f, 0.f, 0.f};
    float mean[2], rstd[2];
#pragma unroll
    for (int mt = 0; mt < 2; ++mt) { mean[mt] = st[2 * (16 * mt + tl)]; rstd[mt] = st[2 * (16 * mt + tl) + 1]; }
#pragma unroll 2
    for (int ks = 0; ks < 16; ++ks) {
        const int k0 = 512 * wid + 32 * ks + 8 * g4;
        const f32x4 ga = *(const f32x4*)(g1 + k0), gb = *(const f32x4*)(g1 + k0 + 4), ba = *(const f32x4*)(b1 + k0), bb = *(const f32x4*)(b1 + k0 + 4);
        bf16x8 ah[2], al[2];
#pragma unroll
        for (int mt = 0; mt < 2; ++mt) {
            const size_t off = (size_t)(row0 + 16 * mt + tl) * DM + k0;
            const u32x4 yr = *(const u32x4*)(Y + off);
            const f32x4 ya = {__uint_as_float(yr.x << 16), __uint_as_float(yr.x & 0xffff0000u), __uint_as_float(yr.y << 16), __uint_as_float(yr.y & 0xffff0000u)};
            const f32x4 yb = {__uint_as_float(yr.z << 16), __uint_as_float(yr.z & 0xffff0000u), __uint_as_float(yr.w << 16), __uint_as_float(yr.w & 0xffff0000u)};
            f32x8 x;
#pragma unroll
            for (int j = 0; j < 4; ++j) { x[j] = (ya[j] - mean[mt]) * rstd[mt] * ga[j] + ba[j]; x[4 + j] = (yb[j] - mean[mt]) * rstd[mt] * gb[j] + bb[j]; }
            const bf16x8 hi = cvt8(x); ah[mt] = hi;
            *(bf16x8*)(X1B + off) = hi;
            f32x8 lo;
#pragma unroll
            for (int j = 0; j < 8; ++j) lo[j] = x[j] - __uint_as_float(((unsigned)(unsigned short)hi[j]) << 16);
            al[mt] = cvt8(lo);
        }
#pragma unroll
        for (int nt = 0; nt < 5; ++nt) {
            const bf16x8 wh = *(const bf16x8*)(WRT + (size_t)(16 * nt + tl) * DM + k0), wl = *(const bf16x8*)(WRT + (size_t)(80 + 16 * nt + tl) * DM + k0);
#pragma unroll
            for (int mt = 0; mt < 2; ++mt) { acc[mt][nt] = MFMA16(ah[mt], wh, acc[mt][nt]); acc[mt][nt] = MFMA16(ah[mt], wl, acc[mt][nt]); acc[mt][nt] = MFMA16(al[mt], wh, acc[mt][nt]); }
        }
    }
#pragma unroll
    for (int mt = 0; mt < 2; ++mt)
#pragma unroll
        for (int nt = 0; nt < 5; ++nt)
#pragma unroll
            for (int i = 0; i < 4; ++i) part[(wid * 32 + 16 * mt + 4 * g4 + i) * 80 + 16 * nt + tl] = acc[mt][nt][i];
    __syncthreads();
    for (int idx = tid; idx < 32 * 80; idx += 512) { float s = 0.f;
#pragma unroll
        for (int w = 0; w < 8; ++w) s += part[w * 2560 + idx];
        logit[idx] = s; }
    __syncthreads();
    if (tid < 32) {
        const float* bg = in[18]; const float* be = in[20];
        const LAS float* lg = logit + tid * 80;
        float gl[8]; int gi = 0; float gm = -3.0e38f;
#pragma unroll
        for (int j = 0; j < 8; ++j) { gl[j] = lg[j] + bg[j]; if (gl[j] > gm) { gm = gl[j]; gi = j; } }
        float den = 0.f;
#pragma unroll
        for (int j = 0; j < 8; ++j) den += __expf(gl[j] - gm);
        const float gw = 1.0f / den;
        float t1 = -3.0e38f, t2 = -3.0e38f; int i1 = 0, i2 = 0;
        for (int j = 0; j < 8; ++j) { const float v = lg[8 + 8 * gi + j] + be[8 * gi + j];
            if (v > t1) { t2 = t1; i2 = i1; t1 = v; i1 = j; } else if (v > t2) { t2 = v; i2 = j; } }
        const float e2 = __expf(t2 - t1), w1 = 1.0f / (1.0f + e2), w2 = e2 * w1;
        const int token = row0 + tid, e0 = 8 * gi + i1, e1 = 8 * gi + i2;
        unsigned* cnt = (unsigned*)(ws + WS_CTL) + CW_CNT;
        int* tokl = (int*)(ws + WS_TOKL); float* wl = (float*)(ws + WS_WL);
        const int p0 = (int)atomicAdd(cnt + 32 * e0, 1u), p1 = (int)atomicAdd(cnt + 32 * e1, 1u);
        tokl[e0 * NTOK + p0] = token; wl[e0 * NTOK + p0] = gw * w1;
        tokl[e1 * NTOK + p1] = token; wl[e1 * NTOK + p1] = gw * w2;
        ((i32x4*)(ws + WS_ROUTE))[token] = (i32x4){e0, p0, e1, p1};
    }
}

namespace egC {
#ifndef EG_PAIR0
#define EG_PAIR0 0
#endif
#ifndef EG_WAUX
#define EG_WAUX 2
#endif
constexpr int EG_ROWS = 320, EG_MT = EG_ROWS / 16;
constexpr int EG_NW = 4, EG_PFW = 3, EG_UNR = 4, EG_WSTG = 16384, EG_ASTG = EG_ROWS * 128;
constexpr int EG_AOFF = EG_NW * EG_WSTG, EG_WLOFF = EG_AOFF + 2 * EG_ASTG, EG_CNTOFF = EG_WLOFF + EG_ROWS * 4;
static_assert(EG_CNTOFF + 768 <= MISC_OFF && EG_UNR % EG_NW == 0 && EG_PFW == EG_NW - 1, "expert GEMM LDS map / ring geometry");

template <int MODE>
__device__ __forceinline__ void eg_unit(LAS unsigned char* lds, const float* const* in, unsigned char* ws, int e, int ugrp, int cnt, int base, int tid_in, int wid, int lane_in) {
    constexpr int K = MODE == 0 ? DM : DFF, LDB = MODE == 0 ? DFF : DM, KST = K / 32, NTG = MODE == 0 ? 1 : 2, TS = KST * NTG;
    constexpr int WROW = MODE == 0 ? 256 : 512;
    int lane; asm volatile("v_mbcnt_lo_u32_b32 %0, -1, 0\n\tv_mbcnt_hi_u32_b32 %0, -1, %0" : "=v"(lane));
    const int tid = wid * 64 + lane;
    bf16_t* H = (bf16_t*)(ws + WS_H); unsigned char* YS = ws + WS_YS;
    const int* tokl = (const int*)(ws + WS_TOKL) + (size_t)e * NTOK; const float* wlst = (const float*)(ws + WS_WL) + (size_t)e * NTOK;
    const int tl = lane & 15, g4 = lane >> 4;
    const bool consumer = wid < 4, wloader = (wid == 4 || wid == 5);
    const int cg = wid & 1, rh = (wid >> 1) & 1;
    const int wl = wid & 1, al = wid & 1;
    const float* wm0 = (MODE == 0 ? in[21] : in[23]) + (size_t)e * DM * DFF; const float* wm1 = (MODE == 0 ? in[22] : in[23]) + (size_t)e * DM * DFF;
    const __amdgpu_buffer_rsrc_t wrs0 = __builtin_amdgcn_make_buffer_rsrc((void*)wm0, 0, DM * DFF * 4, 0x00020000);
    const __amdgpu_buffer_rsrc_t wrs1 = __builtin_amdgcn_make_buffer_rsrc((void*)wm1, 0, DM * DFF * 4, 0x00020000);
    unsigned wvo[2];
#pragma unroll
    for (int x = 0; x < 2; ++x) wvo[x] = MODE == 0 ? (unsigned)((((16 * wl + (lane >> 4)) * LDB) + 4 * ((lane & 15) ^ x)) * 4) : (unsigned)((((16 * wl + (lane >> 5)) * LDB) + 4 * ((lane & 31) ^ x)) * 4);
    const __amdgpu_buffer_rsrc_t ars = __builtin_amdgcn_make_buffer_rsrc(MODE == 0 ? (void*)(ws + WS_X1B) : (void*)(ws + WS_H), 0, MODE == 0 ? NTOK * DM * 2 : 2 * NTOK * DFF * 2, 0x00020000);
    int wfo[4];
#pragma unroll
    for (int t = 0; t < 4; ++t) { const int chunk = MODE == 0 ? 8 * cg + 2 * (tl >> 2) + (t & 1) : 16 * cg + 4 * (tl >> 2) + t;
        wfo[t] = (MODE == 0 ? (t >> 1) * 8192 : 0) + (8 * g4) * WROW + 16 * (chunk ^ (g4 & 1)) + 4 * (tl & 3); }
    const int aoff0 = EG_AOFF + rh * 2048 + tl * 128 + 16 * (g4 ^ (tl & 7)), aoff1 = EG_AOFF + rh * 2048 + tl * 128 + 16 * ((4 + g4) ^ (tl & 7));
    LAS float* wl_lds = (LAS float*)(lds + EG_WLOFF);

    for (int rowp = 0; rowp < cnt; rowp += EG_ROWS) {
        const int nrows = (cnt - rowp) < EG_ROWS ? (cnt - rowp) : EG_ROWS, n_mt = (nrows + 15) >> 4;
        const int n_act = n_mt > rh ? (n_mt - rh + 1) >> 1 : 0;
        const int npc_ = (nrows - 160 * al + 7) >> 3; const int npc = npc_ < 0 ? 0 : (npc_ > 20 ? 20 : npc_);
        __syncthreads();
        if (MODE == 1) { if (tid < EG_ROWS) wl_lds[tid] = tid < nrows ? wlst[rowp + tid] : 0.f; }
        f32x4 acc[4][EG_MT / 2];
#define EG_STEP_BARRIER() do { __builtin_amdgcn_s_barrier(); asm volatile("" ::: "memory"); } while (0)
        if (wloader) {
#define EG_ISSUE_W(s_) do { const int s__ = (s_) < TS ? (s_) : TS - 1; LAS unsigned char* st_ = lds + ((s_) % EG_NW) * EG_WSTG; \
        if (MODE == 0) { const int so_ = ((s__ % KST) * 32 * LDB + ugrp * 64) * 4; \
            _Pragma("unroll") for (int jj = 0; jj < 4; ++jj) { \
                __builtin_amdgcn_raw_ptr_buffer_load_lds(wrs0, (LAS unsigned*)(st_ + (4 * wl + jj) * 1024), 16, wvo[(jj >> 1) & 1], so_ + jj * (4 * LDB * 4), 0, EG_WAUX); \
                __builtin_amdgcn_raw_ptr_buffer_load_lds(wrs1, (LAS unsigned*)(st_ + 8192 + (4 * wl + jj) * 1024), 16, wvo[(jj >> 1) & 1], so_ + jj * (4 * LDB * 4), 0, EG_WAUX); } } \
        else { const int so_ = ((s__ % KST) * 32 * LDB + ugrp * (NTG * 128) + (s__ / KST) * 128) * 4; \
            _Pragma("unroll") for (int jj = 0; jj < 8; ++jj) __builtin_amdgcn_raw_ptr_buffer_load_lds(wrs0, (LAS unsigned*)(st_ + (8 * wl + jj) * 1024), 16, wvo[(jj >> 2) & 1], so_ + jj * (2 * LDB * 4), 0, EG_WAUX); } } while (0)
            asm volatile("s_waitcnt vmcnt(0) lgkmcnt(0)" ::: "memory");
#pragma unroll
            for (int u = 0; u < EG_PFW; ++u) EG_ISSUE_W(u);
            asm volatile("s_waitcnt vmcnt(%0)" :: "n"(8 * (EG_PFW - 1)) : "memory");
            EG_STEP_BARRIER();
#pragma unroll 1
            for (int s = 0; s < TS; ++s) {
                EG_ISSUE_W(s + EG_PFW);
                asm volatile("s_waitcnt vmcnt(%0)" :: "n"(8 * (EG_PFW - 1)) : "memory");
                EG_STEP_BARRIER();
            }
#undef EG_ISSUE_W
        } else if (!consumer) {
            unsigned avo[20];
#pragma unroll
            for (int jj = 0; jj < 20; ++jj) { const int lr = 160 * al + 8 * jj + (lane >> 3); const int lrc = lr < nrows ? lr : 0;
                const unsigned ro = MODE == 0 ? (unsigned)tokl[rowp + lrc] * (DM * 2) : (unsigned)(base + rowp + lrc) * (DFF * 2);
                avo[jj] = ro + 16 * ((lane & 7) ^ ((lane >> 3) & 7)); }
            asm volatile("s_waitcnt vmcnt(0) lgkmcnt(0)" ::: "memory");
#define EG_ISSUE_A(j_) do { LAS unsigned char* st_ = lds + EG_AOFF + ((j_) & 1) * EG_ASTG + (20 * al) * 1024; const int so_ = ((j_) % (KST / 2)) * 128; \
        _Pragma("unroll") for (int jj = 0; jj < 20; ++jj) if (jj < npc) __builtin_amdgcn_raw_ptr_buffer_load_lds(ars, (LAS unsigned*)(st_ + jj * 1024), 16, avo[jj], so_, 0, 0); } while (0)
            EG_ISSUE_A(0);
            asm volatile("s_waitcnt vmcnt(0)" ::: "memory");
            EG_STEP_BARRIER();
#pragma unroll 1
            for (int s = 0; s < TS; s += 2) {
                if ((s >> 1) + 1 < TS / 2) EG_ISSUE_A((s >> 1) + 1);
                EG_STEP_BARRIER();
                asm volatile("s_waitcnt vmcnt(0)" ::: "memory");
                EG_STEP_BARRIER();
            }
#undef EG_ISSUE_A
        } else {
#pragma unroll
            for (int t = 0; t < 4; ++t)
#pragma unroll
                for (int i = 0; i < EG_MT / 2; ++i) acc[t][i] = (f32x4){0.f, 0.f, 0.f, 0.f};
            __builtin_amdgcn_s_waitcnt(0x0070);
            asm volatile("" ::: "memory");
            EG_STEP_BARRIER();
#pragma unroll 1
            for (int s0 = 0; s0 < TS; s0 += EG_UNR) {
#pragma unroll
                for (int u = 0; u < EG_UNR; ++u) {
                    const int s = s0 + u;
                    const LAS unsigned char* wsb = lds + (u % EG_NW) * EG_WSTG;
                    bf16x8 wf[4];
#pragma unroll
                    for (int t = 0; t < 4; ++t) { f32x8 wv;
#pragma unroll
                        for (int j = 0; j < 8; ++j) wv[j] = *(const LAS float*)(wsb + wfo[t] + j * WROW);
                        wf[t] = cvt8(wv); }
                    const LAS unsigned char* ab = lds + ((u >> 1) & 1) * EG_ASTG + ((u & 1) ? aoff1 : aoff0);
                    bf16x8 xf[2][2];
#pragma unroll
                    for (int q = 0; q < 2; ++q) xf[0][q] = *(const LAS bf16x8*)(ab + q * 4096);
#pragma unroll
                    for (int gq = 0; gq < EG_MT / 4; ++gq) {
                        if (gq + 1 < EG_MT / 4) { if (2 * (gq + 1) < n_act) {
#pragma unroll
                            for (int q = 0; q < 2; ++q) xf[(gq + 1) & 1][q] = *(const LAS bf16x8*)(ab + (2 * (gq + 1) + q) * 4096); } }
                        __builtin_amdgcn_sched_barrier(0);
                        if (2 * gq < n_act) {
#pragma unroll
                            for (int q = 0; q < 2; ++q)
#pragma unroll
                                for (int t = 0; t < 4; ++t) acc[t][2 * gq + q] = MFMA16(wf[t], xf[gq & 1][q], acc[t][2 * gq + q]); }
                        __builtin_amdgcn_sched_barrier(0);
                    }
                    if (MODE == 1) { if ((s % KST) == KST - 1) {
                        const int col = ugrp * (NTG * 128) + (s / KST) * 128 + 64 * cg + 16 * g4;
                        int tlo = tl; asm volatile("" : "+v"(tlo));
#pragma unroll
                        for (int j = 0; j < EG_MT / 2; ++j) { if (j < n_act) { const int lr = 16 * (2 * j + rh) + tlo; const float wgt = wl_lds[lr] * YS_SCALE;
                                u32x4 o;
#pragma unroll
                                for (int t = 0; t < 4; ++t) { const f32x4 a = acc[t][j] * wgt; int pk = 0;
                                    pk = __builtin_amdgcn_cvt_pk_fp8_f32(__builtin_amdgcn_fmed3f(a[0], -448.f, 448.f), __builtin_amdgcn_fmed3f(a[1], -448.f, 448.f), pk, false);
                                    pk = __builtin_amdgcn_cvt_pk_fp8_f32(__builtin_amdgcn_fmed3f(a[2], -448.f, 448.f), __builtin_amdgcn_fmed3f(a[3], -448.f, 448.f), pk, true);
                                    o[t] = (unsigned)pk; }
                                if (lr < nrows) *(u32x4*)(YS + (size_t)(base + rowp + lr) * DM + col) = o; }
#pragma unroll
                            for (int t = 0; t < 4; ++t) acc[t][j] = (f32x4){0.f, 0.f, 0.f, 0.f}; } } }
                    asm volatile("s_waitcnt lgkmcnt(0)" ::: "memory");
                    EG_STEP_BARRIER();
                }
            }
            if (MODE == 0) {
            const int col = ugrp * 64 + 32 * cg + 8 * g4;
#pragma unroll
            for (int j = 0; j < EG_MT / 2; ++j) if (j < n_act) { const int lr = 16 * (2 * j + rh) + tl;
                if (lr < nrows) { f32x8 hv;
#pragma unroll
                    for (int hf = 0; hf < 2; ++hf)
#pragma unroll
                        for (int i = 0; i < 4; ++i) { const float v = acc[hf][j][i]; hv[4 * hf + i] = v / (1.0f + __expf(-v)) * acc[2 + hf][j][i]; }
                    *(bf16x8*)(H + (size_t)(base + rowp + lr) * DFF + col) = cvt8(hv); } }
            }
        }
#undef EG_STEP_BARRIER
        asm volatile("s_waitcnt vmcnt(0)" ::: "memory");
        __syncthreads();
#undef EG_ISSUE_W
#undef EG_ISSUE_A
    }
}

template <int MODE>
__device__ __forceinline__ void eg_phase(LAS unsigned char* lds, const float* const* in, unsigned char* ws, int vcu, int G, int tid, int wid, int lane) {
    LAS int* ecnt = (LAS int*)(lds + EG_CNTOFF); LAS int* ebase = ecnt + 64;
    __syncthreads();
    if (tid < 64) { const unsigned* cnt = (const unsigned*)(ws + WS_CTL) + CW_CNT; int c = (int)cnt[32 * tid]; ecnt[tid] = c; }
    __syncthreads();
    if (tid < 64) { int s = 0; for (int j = 0; j < tid; ++j) s += ecnt[j]; ebase[tid] = s; }
    __syncthreads();
    LAS int* eord = ebase + 64;
    if (tid < 64) { const int c = ecnt[tid]; int r = 0;
        for (int j = 0; j < 64; ++j) { const int cj = ecnt[j]; r += (cj > c || (cj == c && j < tid)) ? 1 : 0; }
        eord[r] = tid; }
    __syncthreads();
    if (G == 256 && MODE == 0 && EG_PAIR0) {
        for (int k = 0; k < 2; ++k) { const int e = eord[k == 0 ? (vcu >> 3) : 63 - (vcu >> 3)], ug = vcu & 7; const int c = ecnt[e]; if (c > 0) eg_unit<MODE>(lds, in, ws, e, ug, c, ebase[e], tid, wid, lane); }
    } else if (G == 256 && MODE == 1) {
        for (int k = 0; k < 4; ++k) { const int i = vcu >> 4, ug = vcu & 15; const int e = eord[k == 0 ? i : (k == 1 ? 63 - i : (k == 2 ? 31 - i : 32 + i))]; const int c = ecnt[e]; if (c > 0) eg_unit<MODE>(lds, in, ws, e, ug, c, ebase[e], tid, wid, lane); }
    } else {
        constexpr int NU = MODE == 0 ? 8 : 16;
        for (int u = vcu; u < NEXP * NU; u += G) { const int e = u / NU, ug = u % NU; const int c = ecnt[e]; if (c > 0) eg_unit<MODE>(lds, in, ws, e, ug, c, ebase[e], tid, wid, lane); }
    }
}
}
constexpr int EG_CNTOFF = egC::EG_CNTOFF;
__device__ __forceinline__ void final_phase(LAS unsigned char* lds, const float* const* in, float* out, unsigned char* ws, int vcu, int G, int tid, int wid, int lane) {
    LAS int* ecnt = (LAS int*)(lds + EG_CNTOFF); LAS int* ebase = ecnt + 64;
    __syncthreads();
    if (tid < 64) { const unsigned* cnt = (const unsigned*)(ws + WS_CTL) + CW_CNT; ecnt[tid] = (int)cnt[32 * tid]; }
    __syncthreads();
    if (tid < 64) { int s = 0; for (int j = 0; j < tid; ++j) s += ecnt[j]; ebase[tid] = s; }
    __syncthreads();
    const unsigned char* YS = ws + WS_YS; const bf16_t* X1B = (const bf16_t*)(ws + WS_X1B); const float* g2 = in[24]; const float* b2 = in[25];
    for (int row = vcu * 8 + wid; row < NTOK; row += G * 8) {
        const i32x4 rt = ((const i32x4*)(ws + WS_ROUTE))[row];
        const int a0 = ebase[rt[0]] + rt[1], a1 = ebase[rt[2]] + rt[3];
        f32x4* zp = (f32x4*)(out + (size_t)row * DM) + lane;
        const u32x2* xp = (const u32x2*)(X1B + (size_t)row * DM) + lane;
        const unsigned* y0 = (const unsigned*)(YS + (size_t)a0 * DM) + lane; const unsigned* y1 = (const unsigned*)(YS + (size_t)a1 * DM) + lane;
        f32x4 v[16]; float s = 0.f;
#pragma unroll
        for (int j = 0; j < 16; ++j) { const u32x2 z = xp[64 * j]; const int p = (int)y0[64 * j], q = (int)y1[64 * j];
            v[j][0] = ALPHA * __uint_as_float(z.x << 16) + (__builtin_amdgcn_cvt_f32_fp8(p, 0) + __builtin_amdgcn_cvt_f32_fp8(q, 0)) * (1.0f / YS_SCALE);
            v[j][1] = ALPHA * __uint_as_float(z.x & 0xffff0000u) + (__builtin_amdgcn_cvt_f32_fp8(p, 1) + __builtin_amdgcn_cvt_f32_fp8(q, 1)) * (1.0f / YS_SCALE);
            v[j][2] = ALPHA * __uint_as_float(z.y << 16) + (__builtin_amdgcn_cvt_f32_fp8(p, 2) + __builtin_amdgcn_cvt_f32_fp8(q, 2)) * (1.0f / YS_SCALE);
            v[j][3] = ALPHA * __uint_as_float(z.y & 0xffff0000u) + (__builtin_amdgcn_cvt_f32_fp8(p, 3) + __builtin_amdgcn_cvt_f32_fp8(q, 3)) * (1.0f / YS_SCALE);
            s += (v[j][0] + v[j][1]) + (v[j][2] + v[j][3]); }
        const float mean = wave_sum(s) * (1.0f / DM); float q2 = 0.f;
#pragma unroll
        for (int j = 0; j < 16; ++j) { v[j] = v[j] - mean; q2 += (v[j][0] * v[j][0] + v[j][1] * v[j][1]) + (v[j][2] * v[j][2] + v[j][3] * v[j][3]); }
        const float rstd = __builtin_amdgcn_rsqf(wave_sum(q2) * (1.0f / DM) + LN_EPS);
        int lo_ = lane; asm volatile("" : "+v"(lo_));
        const f32x4* g2p = (const f32x4*)g2 + lo_; const f32x4* b2p = (const f32x4*)b2 + lo_;
#pragma unroll
        for (int j = 0; j < 16; ++j) { const f32x4 gg = g2p[64 * j], bb = b2p[64 * j]; zp[64 * j] = v[j] * rstd * gg + bb;
            if ((j & 3) == 3) asm volatile("" ::: "memory"); }
    }
}
#ifndef MK_N_LAUNCHES
#define MK_N_LAUNCHES 1
#endif
constexpr int N_PHASES = 8;
struct Args { const float* in[26]; float* out; unsigned char* ws; int ph_lo, ph_hi; };

__global__ void __launch_bounds__(512, 2) mk_fwd(Args args) {
    extern __shared__ __attribute__((aligned(16))) unsigned char lds_raw[];
    LAS unsigned char* lds = (LAS unsigned char*)lds_raw;
    const int wid = __builtin_amdgcn_readfirstlane(threadIdx.x >> 6);
#define FRESH_TID() int lane; asm volatile("v_mbcnt_lo_u32_b32 %0, -1, 0\n\tv_mbcnt_hi_u32_b32 %0, -1, %0" : "=v"(lane)); const int tid = wid * 64 + lane;
    const int G = gridDim.x, bx = blockIdx.x;
    const int vcu = (G % 8 == 0) ? (bx % 8) * (G / 8) + bx / 8 : bx;
    unsigned char* ws = args.ws;
    unsigned* ctl = (unsigned*)(ws + WS_CTL);
    volatile LAS unsigned* MISC = (volatile LAS unsigned*)(lds + MISC_OFF);
    { FRESH_TID(); if (tid < 32) MISC[tid] = 0u; }
    __syncthreads();
    const int lo = args.ph_lo, hi = args.ph_hi;
    XcdBarrier bar; bar.bar = ctl + CW_BAR + lo * XCD_BAR_WORDS; bar.x = 0; bar.st = MISC + 8; bar.w = (unsigned)wid;
    if (hi - lo > 1) bar = xcd_barrier_post(ctl + CW_BAR + lo * XCD_BAR_WORDS, MISC + 8);
#ifndef MK_PHASE_MASK
#define MK_PHASE_MASK 255
#endif
#define IN(k) ((((MK_PHASE_MASK) >> (k)) & 1) && lo <= (k) && (k) < hi)
#define SEAM(k) do { if (IN(k) && IN((k) + 1)) xcd_barrier(bar); } while (0)
#ifndef MK_DUP
#define MK_DUP -1
#endif
#define REP(k) for (int rep_ = 0; rep_ < ((MK_DUP) == (k) ? 2 : 1); ++rep_)

    if (IN(0)) REP(0) { FRESH_TID(); p0_prologue(lds, args.in, ws, vcu, G, tid, wid, lane); }
    SEAM(0);
    if (IN(1)) REP(1) {
        pg8::Gemm g{(const bf16_t*)(ws + WS_XB), (const bf16_t*)(ws + WS_WINT), NTOK, DIN, DM};
        pg8::StaticOrder S; S.init(NTOK, DIN, G, bx);
        EpiProj E{(bf16_t*)(ws + WS_QKVUG), (float*)(ws + WS_GSTAT)};
        pg8::gemm_phase<EpiProj, pg8::StaticOrder, true, true>(lds, g, S, E, wid);
    }
    SEAM(1);
    if (IN(2)) {
#ifndef MK_P2_SUB
#define MK_P2_SUB 3
#endif
        if (MK_P2_SUB & 1) REP(2) { FRESH_TID(); attn_phase(lds, args.in, ws, vcu, G, tid, wid, lane); }
        if (MK_P2_SUB & 2) REP(20) { FRESH_TID(); gmlp_phase(lds, args.in, ws, vcu, G, tid, wid, lane); }
    }
    SEAM(2);
    if (IN(3)) REP(3) {
        pg8::Gemm g{(const bf16_t*)(ws + WS_AO), (const bf16_t*)(ws + WS_WOUTT), NTOK, DM, DM};
        pg8::StaticOrder S; S.init(NTOK, DM, G, bx);
        EpiY E{(const bf16_t*)(ws + WS_XB), (bf16_t*)(ws + WS_Y), (float*)(ws + WS_YSTAT), (const float*)(ws + WS_GPART)};
        pg8::gemm_phase<EpiY, pg8::StaticOrder, true, true>(lds, g, S, E, wid);
    }
    SEAM(3);
    if (IN(4)) { FRESH_TID(); for (int rgp = vcu; rgp < NTOK / 32; rgp += G) route_unit(lds, args.in, args.out, ws, rgp, tid, wid, lane); }
    SEAM(4);
    if (IN(5)) REP(5) { FRESH_TID(); egC::eg_phase<0>(lds, args.in, ws, vcu, G, tid, wid, lane); }
    SEAM(5);
    if (IN(6)) REP(6) { FRESH_TID(); egC::eg_phase<1>(lds, args.in, ws, vcu, G, tid, wid, lane); }
    SEAM(6);
    if (IN(7)) { FRESH_TID(); final_phase(lds, args.in, args.out, ws, vcu, G, tid, wid, lane); }
#undef IN
#undef SEAM
}
}

extern "C" void kernel_launch(void* const* d_in, const int* in_sizes, int n_in, void* d_out, int out_size, void* d_ws, size_t ws_size, hipStream_t stream) {
    using namespace mk;
    static int grid = 0;
    if (grid == 0) {
        if (n_in != 26 || out_size != NTOK * DM || ws_size < WS_END) { fprintf(stderr, "kernel_launch: unexpected shapes (n_in %d, out %d, ws %zu)\n", n_in, out_size, ws_size); grid = -1; return; }
        int dev = 0, cus = 0, per_cu = 0;
        if (hipGetDevice(&dev) != hipSuccess || hipDeviceGetAttribute(&cus, hipDeviceAttributeMultiprocessorCount, dev) != hipSuccess) { grid = -1; return; }
        if (hipFuncSetAttribute((const void*)mk_fwd, hipFuncAttributeMaxDynamicSharedMemorySize, LDS_BYTES) != hipSuccess) { fprintf(stderr, "kernel_launch: hipFuncSetAttribute failed\n"); grid = -1; return; }
        if (hipOccupancyMaxActiveBlocksPerMultiprocessor(&per_cu, (const void*)mk_fwd, 512, LDS_BYTES) != hipSuccess || per_cu < 1)
            fprintf(stderr, "kernel_launch: note: occupancy query reports %d blocks per CU\n", per_cu);
        (void)hipGetLastError();
        grid = cus;
    }
    if (grid < 0) return;
    if (hipMemsetAsync((char*)d_ws + WS_CTL, 0, CTL_ZERO_BYTES, stream) != hipSuccess) return;
    Args a{};
    for (int i = 0; i < 26; ++i) a.in[i] = (const float*)d_in[i];
    a.out = (float*)d_out; a.ws = (unsigned char*)d_ws;
#if MK_N_LAUNCHES == 1
    a.ph_lo = 0; a.ph_hi = N_PHASES;
    hipLaunchKernelGGL(mk_fwd, dim3(grid), dim3(512), LDS_BYTES, stream, a);
#else
#ifndef MK_DUP_LAUNCH
#define MK_DUP_LAUNCH -1
#endif
    for (int p = 0; p < N_PHASES; ++p) { a.ph_lo = p; a.ph_hi = p + 1;
        for (int rep = 0; rep < (p == (MK_DUP_LAUNCH) ? 2 : 1); ++rep) hipLaunchKernelGGL(mk_fwd, dim3(grid), dim3(512), LDS_BYTES, stream, a); }
#endif
}
```

```cpp
#include <hip/hip_runtime.h>
#include <cstdio>
#include <cstdint>
namespace pg8 {
#define PG8_LAS __attribute__((address_space(3)))
typedef unsigned short bf16_t;
typedef short bf16x8 __attribute__((ext_vector_type(8)));
typedef float f32x4 __attribute__((ext_vector_type(4)));
typedef unsigned u32x4 __attribute__((ext_vector_type(4)));
constexpr int BM = 256, BK = 64, HALF = 128, HTB = HALF * BK * 2  , STAGE_BYTES = 8 * HTB, NXCD = 8, WGM = 8;

__host__ __device__ __forceinline__ int lds_byte(int r, int c) { const int st = (r >> 4) * 2 + (c >> 5), rr = r & 15, cc = c & 31, ob = rr * 64 + cc * 2; return st * 1024 + (ob ^ (((ob >> 9) & 1) << 5)); }
__host__ __device__ __forceinline__ void stage_rc(int b, int& R, int& C) { const int st = b / 1024, sb = b % 1024, swz = sb ^ (((sb >> 9) & 1) << 5); R = (st >> 1) * 16 + swz / 64; C = (st & 1) * 32 + (swz % 64) / 2; }
__host__ __device__ __forceinline__ int perm32(int rho) { const int n = rho >> 4, i = rho & 15; return 8 * (i >> 2) + 4 * n + (i & 3); }

struct Unit { int pm, pn; };
struct Gemm { const bf16_t* A; const bf16_t* Bt; int M, N, K; };

struct StaticOrder {
    int nM, nN, nwg, G, c;
    __host__ __device__ void init(int M, int N, int G_, int c_) { nM = M / BM; nN = N / BM; nwg = nM * nN; G = G_; c = c_; }
    __host__ __device__ bool next(int i, Unit& u) const {
        const long L = (long)i * G + c; if (L >= nwg) return false;
        int wgid = (int)L; { const int q = nwg / NXCD, r = nwg % NXCD, xcd = wgid % NXCD, off = wgid / NXCD; wgid = (xcd < r ? xcd * (q + 1) : r * (q + 1) + (xcd - r) * q) + off; }
        const int nig = WGM * nN, gid = wgid / nig, fm = gid * WGM, gsz = (nM - fm) < WGM ? (nM - fm) : WGM;
        u.pm = fm + ((wgid % nig) % gsz); u.pn = (wgid % nig) / gsz; return true;
    }
    __device__ __forceinline__ int row_panel(int i) const {
        const long L = (long)i * G + c; if (L >= nwg) return -1;
        int wgid = (int)L; { const int q = nwg / NXCD, r = nwg % NXCD, xcd = wgid % NXCD, off = wgid / NXCD; wgid = (xcd < r ? xcd * (q + 1) : r * (q + 1) + (xcd - r) * q) + off; }
        const int nig = WGM * nN, gid = wgid / nig, fm = gid * WGM, gsz = (nM - fm) < WGM ? (nM - fm) : WGM;
        return fm + ((wgid % nig) % gsz);
    }
    __device__ __forceinline__ void a_ready(const Unit&) const {}
    __device__ __forceinline__ void done(const Unit&) const {}
};
__device__ __forceinline__ unsigned cvt_pk_bf16(float lo, float hi) { unsigned r; asm volatile("v_cvt_pk_bf16_f32 %0, %1, %2" : "=v"(r) : "v"(lo), "v"(hi)); return r; }
typedef float f32x2 __attribute__((ext_vector_type(2)));
__device__ __forceinline__ f32x2 gelu_pk(f32x2 v) {
    const f32x2 av = __builtin_elementwise_abs(v), d = av * 0.2316418882f + 1.0f;
    f32x2 t; t.x = __builtin_amdgcn_rcpf(d.x); t.y = __builtin_amdgcn_rcpf(d.y);
    f32x2 q = t * 0.5307027145f + (-0.7265760135f); q = q * t + 0.7107068705f; q = q * t + (-0.142248368f); q = q * t + 0.127414796f; q = q * t;
    const f32x2 s = (v * v) * (-0.72134752044f);
    f32x2 e; e.x = __builtin_amdgcn_exp2f(s.x); e.y = __builtin_amdgcn_exp2f(s.y);
    const f32x2 m = v * (q * e), r = v - m;
    f32x2 o; o.x = v.x < 0.f ? m.x : r.x; o.y = v.y < 0.f ? m.y : r.y; return o;
}
template <class Epi, class Sched, bool ALIGN_EPI = false, bool SP2 = false>
__device__ __forceinline__ void gemm_phase(PG8_LAS unsigned char* lds, const Gemm g, const Sched& S, const Epi& E, int wid) {
    int lane; asm volatile("v_mbcnt_lo_u32_b32 %0, -1, 0\n\tv_mbcnt_hi_u32_b32 %0, -1, %0" : "=v"(lane));
    const int tid = wid * 64 + lane, wr = wid >> 2, wc = wid & 3, fr = lane & 15, fq = lane >> 4;
    const int K = g.K, nt = K / BK;
    unsigned voffA[2], voffB[2];
#pragma unroll
    for (int i = 0; i < 2; ++i) { int R, C; stage_rc(tid * 16 + i * 8192, R, C); const int Rb = Epi::PERM ? ((R & ~31) + perm32(R & 31)) : R;
        voffA[i] = (unsigned)(R * K + C) * 2u; voffB[i] = (unsigned)(Rb * K + C) * 2u; }
    const size_t kstep = (size_t)(BK * 2);
    const size_t hstep = (size_t)HALF * K * 2;
    const size_t tstep = 2 * hstep;
    const unsigned ldsw = (unsigned)wid * 1024u;
    const int aoff = lds_byte(wr * 64 + fr, fq * 8), boff = lds_byte(wc * 32 + fr, fq * 8);
#define PG8_SA(b, h) (((b) * 2 + (h)) * HTB)
#define PG8_SB(b, h) ((4 + (b) * 2 + (h)) * HTB)
#define PG8_STAGE(bufoff, gbase, voff) do { _Pragma("unroll") for (int _i = 0; _i < 2; ++_i) \
        __builtin_amdgcn_global_load_lds((const unsigned*)((const char*)(gbase) + (voff)[_i]), (PG8_LAS unsigned*)(lds + (bufoff) + ldsw + _i * 8192), 16, 0, 0); } while (0)
#define PG8_LDA(dst, b, h) do { _Pragma("unroll") for (int m = 0; m < 4; ++m) _Pragma("unroll") for (int k = 0; k < 2; ++k) dst[m][k] = *(const PG8_LAS bf16x8*)(lds + PG8_SA(b, h) + aoff + m * 2048 + k * 1024); } while (0)
#define PG8_LDB(dst, b, h) do { _Pragma("unroll") for (int n = 0; n < 2; ++n) _Pragma("unroll") for (int k = 0; k < 2; ++k) dst[n][k] = *(const PG8_LAS bf16x8*)(lds + PG8_SB(b, h) + boff + n * 2048 + k * 1024); } while (0)
#define PG8_MMA(ai, bj, At, Bt) do { __builtin_amdgcn_s_setprio(1); _Pragma("unroll") for (int m = 0; m < 4; ++m) _Pragma("unroll") for (int n = 0; n < 2; ++n) _Pragma("unroll") for (int k = 0; k < 2; ++k) \
        acc[ai][bj][m][n] = __builtin_amdgcn_mfma_f32_16x16x32_bf16(Bt[n][k], At[m][k], acc[ai][bj][m][n], 0, 0, 0); __builtin_amdgcn_s_setprio(0); } while (0)
#define PG8_WAIT_V(n) asm volatile("s_waitcnt vmcnt(" #n ")" ::: "memory")
#define PG8_WAIT_L(n) asm volatile("s_waitcnt lgkmcnt(" #n ")" ::: "memory")
#define PG8_BAR __builtin_amdgcn_s_barrier()
#define PG8_SCHED __builtin_amdgcn_sched_barrier(0)
    Unit cur, nxt; int ui = 0;
    if (!S.next(0, cur)) return;
    f32x4 acc[2][2][4][2];
#pragma unroll
    for (int a = 0; a < 2; ++a)
#pragma unroll
        for (int b = 0; b < 2; ++b)
#pragma unroll
            for (int m = 0; m < 4; ++m)
#pragma unroll
                for (int n = 0; n < 2; ++n) acc[a][b][m][n] = (f32x4){0.f, 0.f, 0.f, 0.f};
    bf16x8 At[4][2], B0[2][2], B1[2][2];
    const char* cA = (const char*)g.A + (size_t)cur.pm * tstep; const char* cB = (const char*)g.Bt + (size_t)cur.pn * tstep;
    S.a_ready(cur);
    if constexpr (SP2) {
        PG8_STAGE(PG8_SB(0, 0), cB, voffB); PG8_STAGE(PG8_SB(0, 1), cB + hstep, voffB); PG8_STAGE(PG8_SA(0, 0), cA, voffA); PG8_STAGE(PG8_SA(0, 1), cA + hstep, voffA);
        if (wr == 1) PG8_BAR;
        PG8_WAIT_V(2); PG8_BAR;
        PG8_STAGE(PG8_SB(1, 0), cB + kstep, voffB); PG8_STAGE(PG8_SA(1, 0), cA + kstep, voffA); PG8_STAGE(PG8_SB(1, 1), cB + hstep + kstep, voffB);
        PG8_WAIT_V(6); PG8_BAR;
    } else {
        PG8_STAGE(PG8_SB(0, 0), cB, voffB); PG8_STAGE(PG8_SA(0, 0), cA, voffA); PG8_STAGE(PG8_SB(0, 1), cB + hstep, voffB); PG8_STAGE(PG8_SA(0, 1), cA + hstep, voffA);
        if (wr == 1) PG8_BAR;
        PG8_WAIT_V(4); PG8_BAR;
        PG8_STAGE(PG8_SB(1, 0), cB + kstep, voffB); PG8_STAGE(PG8_SA(1, 0), cA + kstep, voffA); PG8_STAGE(PG8_SB(1, 1), cB + hstep + kstep, voffB);
        PG8_WAIT_V(6); PG8_BAR;
    }
    for (;;) {
        const bool has_next = S.next(ui + 1, nxt);
        const char* nA = has_next ? (const char*)g.A + (size_t)nxt.pm * tstep : cA; const char* nB = has_next ? (const char*)g.Bt + (size_t)nxt.pn * tstep : cB;
        for (int t = 0; t < nt; t += 2) {
            const bool last = (t == nt - 2);
            const char* a1 = cA + (size_t)(t + 1) * kstep;
            const char* a2 = last ? nA : cA + (size_t)(t + 2) * kstep; const char* b2 = last ? nB : cB + (size_t)(t + 2) * kstep;
            const char* a3 = a2 + kstep; const char* b3 = b2 + kstep;
            if (last && has_next) S.a_ready(nxt);
            if constexpr (Epi::MIDK) { if (t == nt / 2) E.midk(acc, cur, wr, wc, fr, fq, ui); }
            if constexpr (SP2) {
            PG8_LDB(B0, 0, 0); PG8_LDB(B1, 0, 1); PG8_SCHED; PG8_LDA(At, 0, 0); PG8_STAGE(PG8_SA(1, 1), a1 + hstep, voffA);
            PG8_WAIT_V(8); PG8_WAIT_L(0); PG8_BAR; PG8_MMA(0, 0, At, B0); PG8_MMA(0, 1, At, B1); PG8_BAR; PG8_SCHED;
            PG8_LDA(At, 0, 1); PG8_STAGE(PG8_SB(0, 0), b2, voffB); PG8_STAGE(PG8_SB(0, 1), b2 + hstep, voffB); PG8_STAGE(PG8_SA(0, 0), a2, voffA);
            PG8_WAIT_V(8); PG8_WAIT_L(0); PG8_BAR; PG8_MMA(1, 0, At, B0); PG8_MMA(1, 1, At, B1); PG8_BAR; PG8_SCHED;
            PG8_LDB(B0, 1, 0); PG8_LDB(B1, 1, 1); PG8_SCHED; PG8_LDA(At, 1, 0); PG8_STAGE(PG8_SA(0, 1), a2 + hstep, voffA);
            PG8_WAIT_V(8); PG8_WAIT_L(0); PG8_BAR; PG8_MMA(0, 0, At, B0); PG8_MMA(0, 1, At, B1); PG8_BAR; PG8_SCHED;
            PG8_LDA(At, 1, 1); PG8_STAGE(PG8_SB(1, 0), b3, voffB); PG8_STAGE(PG8_SB(1, 1), b3 + hstep, voffB); PG8_STAGE(PG8_SA(1, 0), a3, voffA);
            PG8_WAIT_V(8); PG8_WAIT_L(0); PG8_BAR; PG8_MMA(1, 0, At, B0); PG8_MMA(1, 1, At, B1); PG8_BAR; PG8_SCHED;
            } else {
            PG8_LDB(B0, 0, 0); PG8_SCHED; PG8_LDA(At, 0, 0); PG8_STAGE(PG8_SA(1, 1), a1 + hstep, voffA);
            PG8_WAIT_L(8); PG8_BAR; PG8_WAIT_L(0); PG8_MMA(0, 0, At, B0); PG8_BAR; PG8_SCHED;
            PG8_LDB(B1, 0, 1); PG8_STAGE(PG8_SB(0, 0), b2, voffB);
            PG8_BAR; PG8_WAIT_L(0); PG8_MMA(0, 1, At, B1); PG8_BAR;
            PG8_LDA(At, 0, 1); PG8_STAGE(PG8_SA(0, 0), a2, voffA);
            PG8_BAR; PG8_WAIT_L(0); PG8_MMA(1, 0, At, B0); PG8_BAR; PG8_SCHED;
            PG8_STAGE(PG8_SB(0, 1), b2 + hstep, voffB);
            PG8_WAIT_V(6); PG8_BAR; PG8_MMA(1, 1, At, B1); PG8_BAR;
            PG8_LDB(B0, 1, 0); PG8_SCHED; PG8_LDA(At, 1, 0); PG8_STAGE(PG8_SA(0, 1), a2 + hstep, voffA);
            PG8_WAIT_L(8); PG8_BAR; PG8_WAIT_L(0); PG8_MMA(0, 0, At, B0); PG8_BAR; PG8_SCHED;
            PG8_LDB(B1, 1, 1); PG8_STAGE(PG8_SB(1, 0), b3, voffB);
            PG8_BAR; PG8_WAIT_L(0); PG8_MMA(0, 1, At, B1); PG8_BAR;
            PG8_LDA(At, 1, 1); PG8_STAGE(PG8_SA(1, 0), a3, voffA);
            PG8_BAR; PG8_WAIT_L(0); PG8_MMA(1, 0, At, B0); PG8_BAR; PG8_SCHED;
            PG8_STAGE(PG8_SB(1, 1), b3 + hstep, voffB);
            PG8_WAIT_V(6); PG8_BAR; PG8_MMA(1, 1, At, B1); PG8_BAR;
            }
        }
        if constexpr (ALIGN_EPI) { if (wr == 0) PG8_BAR; }
        if constexpr (!Epi::AFTER_DRAIN) { E(acc, cur, wr, wc, fr, fq); S.done(cur); }
        if (!has_next) break;
#pragma unroll
        for (int a = 0; a < 2; ++a)
#pragma unroll
            for (int b = 0; b < 2; ++b)
#pragma unroll
                for (int m = 0; m < 4; ++m)
#pragma unroll
                    for (int n = 0; n < 2; ++n) acc[a][b][m][n] = (f32x4){0.f, 0.f, 0.f, 0.f};
        cur = nxt; cA = nA; cB = nB; ++ui;
        if constexpr (ALIGN_EPI) { if (wr == 1) PG8_BAR; }
    }
    PG8_WAIT_V(0);
    if constexpr (!ALIGN_EPI) { if (wr == 0) PG8_BAR; }
    PG8_BAR;
    if constexpr (Epi::AFTER_DRAIN) { E.fused(acc, cur, wr, wc, fr, fq, lds, wid, lane); S.done(cur); }
#undef PG8_SA
#undef PG8_SB
#undef PG8_STAGE
#undef PG8_LDA
#undef PG8_LDB
#undef PG8_MMA
#undef PG8_WAIT_V
#undef PG8_WAIT_L
#undef PG8_BAR
#undef PG8_SCHED
}
}
#define XB_TMO      128
#define XB_XCNT(j)  (256  + 64 * (j))
#define XB_XSUB(j)  (1280 + 64 * (j))
#define XB_XGEN(j)  (2304 + 64 * (j))
#define XB_TOP      3328
#define XB_TOPGEN   3392
#define XCD_BAR_WORDS 3456
#define XB_SPIN_CAP (1u << 18)
#define LAS __attribute__((address_space(3)))

__device__ __forceinline__ unsigned xb_ld(unsigned* p)              { return __hip_atomic_load(p, __ATOMIC_RELAXED, __HIP_MEMORY_SCOPE_AGENT); }
__device__ __forceinline__ unsigned xb_add(unsigned* p, unsigned v) { return __hip_atomic_fetch_add(p, v, __ATOMIC_RELAXED, __HIP_MEMORY_SCOPE_AGENT); }
__device__ __forceinline__ unsigned xb_xcc_id() { return (unsigned)__builtin_amdgcn_s_getreg((3 << 11) | 20) & 0xFu; }
#define XB_SPIN(cond, bar) do { unsigned _sp = 0; while (cond) { __builtin_amdgcn_s_sleep(1); \
    if ((++_sp & 255u) == 0u) { if (xb_ld(&(bar)[XB_TMO])) break; if (_sp > XB_SPIN_CAP) { atomicAdd(&(bar)[XB_TMO], 1u); break; } } } } while (0)

__device__ __forceinline__ bool xb_lane0() { int l; asm volatile("v_mbcnt_lo_u32_b32 %0, -1, 0\n\tv_mbcnt_hi_u32_b32 %0, -1, %0" : "=v"(l)); return l == 0; }
struct XcdBarrier {
    unsigned w;
    unsigned* bar; unsigned x;
    volatile LAS unsigned* st;
};

__device__ __forceinline__ XcdBarrier xcd_barrier_post(unsigned* bar, volatile LAS unsigned* st) {
    XcdBarrier b; b.bar = bar; b.x = xb_xcc_id(); b.st = st; b.w = (unsigned)__builtin_amdgcn_readfirstlane(threadIdx.x >> 6);
    if (b.w == 0u && xb_lane0()) (void)xb_add(&bar[XB_XCNT(b.x)], 1u);
    return b;
}
__device__ __forceinline__ void xcd_barrier_complete(unsigned* bar, unsigned x, unsigned& nloc, unsigned& nx) {
    const unsigned G = gridDim.x * gridDim.y * gridDim.z;
    unsigned sum, cnt, mine, sp = 0u;
    for (;;) {
        sum = 0u; cnt = 0u; mine = 0u;
#pragma unroll
        for (unsigned j = 0; j < 16; ++j) { const unsigned c = xb_ld(&bar[XB_XCNT(j)]); sum += c; cnt += (c > 0u) ? 1u : 0u; mine = (j == x) ? c : mine; }
        if (sum == G) break;
        __builtin_amdgcn_s_sleep(1);
        if ((++sp & 255u) == 0u) { if (xb_ld(&bar[XB_TMO])) break; if (sp > XB_SPIN_CAP) { atomicAdd(&bar[XB_TMO], 1u); break; } }
    }
    nloc = mine > 0u ? mine : 1u; nx = cnt > 0u ? cnt : 1u;
}

__device__ __forceinline__ void xcd_barrier(const XcdBarrier& b) {
    asm volatile("s_waitcnt vmcnt(0)" ::: "memory");
    __syncthreads();
    if (b.w == 0u && xb_lane0()) {
        unsigned* bar = b.bar;
        __builtin_amdgcn_s_waitcnt(0);
        unsigned nloc = b.st[0], nx = b.st[1];
        if (nloc == 0u) { xcd_barrier_complete(bar, b.x, nloc, nx); b.st[0] = nloc; b.st[1] = nx; }
        const unsigned old = xb_add(&bar[XB_XSUB(b.x)], 1u);
        const unsigned gen = old / nloc;
        if (old + 1u == (gen + 1u) * nloc) {
            __builtin_amdgcn_fence(__ATOMIC_RELEASE, "agent");
            asm volatile("s_waitcnt vmcnt(0)" ::: "memory");
            const unsigned og = xb_add(&bar[XB_TOP], 1u);
            const unsigned tg = og / nx;
            if (og + 1u == (tg + 1u) * nx) xb_add(&bar[XB_TOPGEN], 1u);
            else XB_SPIN(xb_ld(&bar[XB_TOPGEN]) == tg, bar);
            __builtin_amdgcn_fence(__ATOMIC_ACQUIRE, "agent");
            xb_add(&bar[XB_XGEN(b.x)], 1u);
            asm volatile("s_waitcnt vmcnt(0)" ::: "memory");
        } else {
            XB_SPIN(xb_ld(&bar[XB_XGEN(b.x)]) == gen, bar);
            __builtin_amdgcn_fence(__ATOMIC_ACQUIRE, "agent");
            asm volatile("s_waitcnt vmcnt(0)" ::: "memory");
        }
    }
    __syncthreads();
}
namespace mk {
using pg8::bf16x8; using pg8::f32x4; using pg8::u32x4; using pg8::bf16_t; using pg8::f32x2; using pg8::gelu_pk;
typedef float f32x16 __attribute__((ext_vector_type(16)));
typedef float f32x8 __attribute__((ext_vector_type(8)));
typedef short s16x4 __attribute__((ext_vector_type(4)));
typedef unsigned u32x2 __attribute__((ext_vector_type(2)));
typedef __bf16 nbf16x8 __attribute__((ext_vector_type(8)));
typedef __bf16 nbf16x4 __attribute__((ext_vector_type(4)));
typedef int i32x4 __attribute__((ext_vector_type(4)));

constexpr int NTOK = 8192, DM = 4096, SEQ = 2048, DIN = 10240, SW = 2048;
constexpr int NEXP = 64, DFF = 512;
constexpr float LN_EPS = 1e-5f;
constexpr float ALPHA = 1.189207115002721f;
constexpr float LOG2E = 1.4426950408889634f;
constexpr float QSCALE = 0.08838834764831845f * 1.4426950408889634f;
constexpr float NEG_BIG = -1e30f;
constexpr float LAMBDA_INIT = 0.2f;

constexpr size_t MiB = 1u << 20;
constexpr size_t WS_CTL = 0, CTL_ZERO_BYTES = 160 * 1024;
constexpr size_t WS_XB = 2 * MiB;
constexpr size_t WS_WINT = WS_XB + 64 * MiB;
constexpr size_t WS_WOUTT = WS_WINT + 80 * MiB;
constexpr size_t WS_WRT = WS_WOUTT + 32 * MiB;
constexpr size_t WS_QKVUG = WS_WRT + 2 * MiB;
constexpr size_t WS_GSTAT = WS_QKVUG + 160 * MiB;
constexpr size_t WS_AO = WS_GSTAT + 2 * MiB;
constexpr size_t WS_Y = WS_AO + 64 * MiB;
constexpr size_t WS_X1B = WS_Y + 128 * MiB;
constexpr size_t WS_ROUTE = WS_X1B + 64 * MiB;
constexpr size_t WS_TOKL = WS_ROUTE + 1 * MiB;
constexpr size_t WS_WL = WS_TOKL + 2 * MiB;
constexpr size_t WS_H = WS_WL + 2 * MiB;
constexpr size_t WS_YS = WS_H + 16 * MiB;
constexpr float YS_SCALE = 64.0f;
constexpr size_t WS_YSTAT = WS_YS + 128 * MiB;
constexpr size_t WS_GPART = WS_YSTAT + 4 * MiB;
constexpr size_t WS_END = WS_GPART + 1 * MiB;
constexpr int CW_CNT = 4096;
constexpr int CW_BAR = 8192;
constexpr int LDS_BYTES = 163840;
constexpr int MISC_OFF = LDS_BYTES - 256;

__device__ __forceinline__ float bf2f(unsigned short b) { return __uint_as_float(((unsigned)b) << 16); }
__device__ __forceinline__ unsigned f2bf(float f) { unsigned u = __float_as_uint(f); return (u + 0x7fffu + ((u >> 16) & 1u)) >> 16; }
typedef __bf16 nbf16x2 __attribute__((ext_vector_type(2)));
typedef float f32x2_ __attribute__((ext_vector_type(2)));
__device__ __forceinline__ unsigned pk2(float lo, float hi) { const f32x2_ v = {lo, hi}; return __builtin_bit_cast(unsigned, __builtin_convertvector(v, nbf16x2)); }
__device__ __forceinline__ bf16x8 cvt8(f32x8 v) { return __builtin_bit_cast(bf16x8, __builtin_convertvector(v, nbf16x8)); }
__device__ __forceinline__ s16x4 cvt4(f32x4 v) { return __builtin_bit_cast(s16x4, __builtin_convertvector(v, nbf16x4)); }
template <int CTRL> __device__ __forceinline__ float dppx(float v) { return __int_as_float(__builtin_amdgcn_update_dpp(0, __float_as_int(v), CTRL, 0xF, 0xF, true)); }
__device__ __forceinline__ float xadd16(float s) { const unsigned u = __float_as_uint(s); const auto r = __builtin_amdgcn_permlane16_swap(u, u, false, false); return __uint_as_float((unsigned)r[0]) + __uint_as_float((unsigned)r[1]); }
__device__ __forceinline__ float xadd32(float s) { const unsigned u = __float_as_uint(s); const auto r = __builtin_amdgcn_permlane32_swap(u, u, false, false); return __uint_as_float((unsigned)r[0]) + __uint_as_float((unsigned)r[1]); }
__device__ __forceinline__ float xmax32(float s) { const unsigned u = __float_as_uint(s); const auto r = __builtin_amdgcn_permlane32_swap(u, u, false, false); return fmaxf(__uint_as_float((unsigned)r[0]), __uint_as_float((unsigned)r[1])); }
__device__ __forceinline__ float xadd1(float v) { return v + dppx<0xB1>(v); }
__device__ __forceinline__ float xadd2(float v) { return v + dppx<0x4E>(v); }
__device__ __forceinline__ float row_sum16(float v) { v = xadd1(v); v = xadd2(v); v += dppx<0x141>(v); v += dppx<0x140>(v); return v; }
__device__ __forceinline__ float wave_sum(float v) { return xadd32(xadd16(row_sum16(v))); }
#define MFMA32(a, b, c) __builtin_amdgcn_mfma_f32_32x32x16_bf16((a), (b), (c), 0, 0, 0)
#define MFMA16(a, b, c) __builtin_amdgcn_mfma_f32_16x16x32_bf16((a), (b), (c), 0, 0, 0)

template <bool SCALE>
__device__ __forceinline__ void p0_transpose_item(const float* W, int K, int N, bf16_t* WT, LAS float* scr, int item, int lane,
                                                  const float* subln_g, const float* beta_attn, const float* beta_gmlp) {
    const int nblk = N / 64, kb = item / nblk, nb = item % nblk, k0 = 64 * kb, n0 = 64 * nb;
    float scv = 1.0f;
    if (SCALE) { const int k = k0 + lane; scv = (k0 < SW) ? subln_g[k & 255] * (1.0f - LAMBDA_INIT) * beta_attn[k] : beta_gmlp[k - SW]; }
#pragma unroll
    for (int hb = 0; hb < 2; ++hb) {
        float v[32];
#pragma unroll
        for (int i = 0; i < 32; ++i) v[i] = __builtin_nontemporal_load(W + (size_t)(k0 + 32 * hb + i) * N + n0 + lane);
#pragma unroll
        for (int i = 0; i < 32; ++i) {
            const int kk = 32 * hb + i; float t = v[i];
            if (SCALE) t *= __int_as_float(__builtin_amdgcn_readlane(__float_as_int(scv), kk));
            scr[kk * 65 + lane] = t; }
    }
    asm volatile("s_waitcnt lgkmcnt(0)" ::: "memory");
    const int c = lane & 7;
#pragma unroll
    for (int j = 0; j < 8; ++j) { const int n = (lane >> 3) + 8 * j; const LAS float* s = scr + (8 * c) * 65 + n;
        u32x4 o; o.x = pk2(s[0 * 65], s[1 * 65]); o.y = pk2(s[2 * 65], s[3 * 65]); o.z = pk2(s[4 * 65], s[5 * 65]); o.w = pk2(s[6 * 65], s[7 * 65]);
        *(u32x4*)(WT + (size_t)(n0 + n) * K + (SCALE ? ((k0 + SW) & (DM - 1)) : k0) + 8 * c) = o; }
    asm volatile("s_waitcnt lgkmcnt(0)" ::: "memory");
}

__device__ __forceinline__ void p0_prologue(LAS unsigned char* lds, const float* const* in, unsigned char* ws, int vcu, int G, int tid, int wid, int lane) {
    const float* x = in[0]; const float* w_in = in[1]; const float* w_out = in[2];
    bf16_t* XB = (bf16_t*)(ws + WS_XB); bf16_t* WINT = (bf16_t*)(ws + WS_WINT); bf16_t* WOUTT = (bf16_t*)(ws + WS_WOUTT); bf16_t* WRT = (bf16_t*)(ws + WS_WRT);
    { const size_t nch = (size_t)NTOK * DM / 8, nthr = (size_t)G * 512; const f32x4* xi = (const f32x4*)x; u32x4* xo = (u32x4*)XB;
      for (size_t i = (size_t)vcu * 512 + tid; i < nch; i += 4 * nthr) {
          f32x4 a[4], b[4];
#pragma unroll
          for (int q = 0; q < 4; ++q) { const size_t c = (i + q * nthr) < nch ? (i + q * nthr) : i; a[q] = __builtin_nontemporal_load(xi + 2 * c); b[q] = __builtin_nontemporal_load(xi + 2 * c + 1); }
#pragma unroll
          for (int q = 0; q < 4; ++q) { f32x8 v = {a[q][0], a[q][1], a[q][2], a[q][3], b[q][0], b[q][1], b[q][2], b[q][3]}; if (i + q * nthr < nch) xo[i + q * nthr] = __builtin_bit_cast(u32x4, cvt8(v)); } } }
    LAS float* scr = (LAS float*)(lds + wid * 16896);
    const int gw = vcu * 8 + wid, NGW = G * 8;
    constexpr int I_IN = (DM / 64) * (DIN / 64), I_OUT = (DM / 64) * (DM / 64);
    for (int it = gw; it < I_IN + I_OUT; it += NGW) {
        if (it < I_IN) p0_transpose_item<false>(w_in, DM, DIN, WINT, scr, it, lane, nullptr, nullptr, nullptr);
        else p0_transpose_item<true>(w_out, DM, DM, WOUTT, scr, it - I_IN, lane, in[7], in[8], in[13]);
    }
    { const float* wg = in[17]; const float* we = in[19];
      for (int i = vcu * 512 + tid; i < 80 * DM; i += G * 512) { const int j = i / DM, c = i % DM;
          const float v = j < 8 ? wg[c * 8 + j] : (j < 72 ? we[c * 64 + (j - 8)] : 0.f);
          const unsigned hi = f2bf(v); const float r = v - __uint_as_float(hi << 16);
          WRT[i] = (bf16_t)hi; WRT[80 * DM + i] = (bf16_t)f2bf(r); } }
}

struct EpiProj {
    static constexpr bool PERM = true, AFTER_DRAIN = false, MIDK = false;
    bf16_t* base; float* gstat;
    __device__ __forceinline__ void operator()(const f32x4 (&acc)[2][2][4][2], const pg8::Unit& u, int wr, int wc, int fr, int fq) const {
        const int sect = u.pn >> 3, colt = (u.pn & 7) * 256;
        bf16_t* O = base + (size_t)sect * ((size_t)NTOK * SW);
        const int row0 = u.pm * 256 + wr * 64 + fr, col0 = colt + wc * 32 + 8 * fq;
#pragma unroll
        for (int ai = 0; ai < 2; ++ai)
#pragma unroll
            for (int m = 0; m < 4; ++m) {
                const int row = row0 + ai * 128 + m * 16;
                bf16_t* rowp = O + (size_t)row * SW + col0; float s1 = 0.f, s2 = 0.f;
#pragma unroll
                for (int bj = 0; bj < 2; ++bj) {
                    f32x4 v0 = acc[ai][bj][m][0], v1 = acc[ai][bj][m][1];
                    if (sect == 0) { v0 *= QSCALE; v1 *= QSCALE; }
                    if (sect >= 3) { f32x2 a = gelu_pk((f32x2){v0[0], v0[1]}), b = gelu_pk((f32x2){v0[2], v0[3]}), c = gelu_pk((f32x2){v1[0], v1[1]}), d = gelu_pk((f32x2){v1[2], v1[3]});
                        v0 = (f32x4){a.x, a.y, b.x, b.y}; v1 = (f32x4){c.x, c.y, d.x, d.y}; }
                    if (sect == 4) { s1 += (v0[0] + v0[1]) + (v0[2] + v0[3]) + (v1[0] + v1[1]) + (v1[2] + v1[3]);
                        s2 += (v0[0] * v0[0] + v0[1] * v0[1]) + (v0[2] * v0[2] + v0[3] * v0[3]) + (v1[0] * v1[0] + v1[1] * v1[1]) + (v1[2] * v1[2] + v1[3] * v1[3]); }
                    f32x8 v8 = {v0[0], v0[1], v0[2], v0[3], v1[0], v1[1], v1[2], v1[3]};
                    *(u32x4*)(rowp + bj * 128) = __builtin_bit_cast(u32x4, cvt8(v8));
                }
                if (sect == 4) { s1 = xadd32(xadd16(s1)); s2 = xadd32(xadd16(s2));
                    if (fq == 0) *(f32x2*)(gstat + ((size_t)row * 32 + (u.pn & 7) * 4 + wc) * 2) = (f32x2){s1, s2}; }
            }
    }
};

struct EpiY {
    static constexpr bool PERM = true, AFTER_DRAIN = false, MIDK = true;
    const bf16_t* xb; bf16_t* Y; float* ystat; const float* gpart;
    const LAS float* rst;
    __device__ __forceinline__ void midk(f32x4 (&acc)[2][2][4][2], const pg8::Unit& u, int wr, int wc, int fr, int fq, int ui) const {
        int fro = fr; asm volatile("" : "+v"(fro));
        const LAS float* rp = rst + 256 * ui + wr * 64 + fro;
#pragma unroll
        for (int ai = 0; ai < 2; ++ai)
#pragma unroll
            for (int m = 0; m < 4; ++m) { const float rs = rp[ai * 128 + m * 16];
#pragma unroll
                for (int bj = 0; bj < 2; ++bj)
#pragma unroll
                    for (int n = 0; n < 2; ++n) acc[ai][bj][m][n] *= rs; }
    }
    __device__ __forceinline__ void operator()(const f32x4 (&acc)[2][2][4][2], const pg8::Unit& u, int wr, int wc, int fr, int fq) const {
        const int row0 = u.pm * 256 + wr * 64 + fr, col0 = u.pn * 256 + wc * 32 + 8 * fq;
#pragma unroll
        for (int ai = 0; ai < 2; ++ai)
#pragma unroll
            for (int m = 0; m < 4; ++m) { const int row = row0 + ai * 128 + m * 16; const size_t off = (size_t)row * DM + col0; float s1 = 0.f, s2 = 0.f;
#pragma unroll
                for (int bj = 0; bj < 2; ++bj) { const u32x4 xr = *(const u32x4*)(xb + off + bj * 128);
                    f32x8 y;
                    y[0] = ALPHA * __uint_as_float(xr.x << 16) + acc[ai][bj][m][0][0]; y[1] = ALPHA * __uint_as_float(xr.x & 0xffff0000u) + acc[ai][bj][m][0][1];
                    y[2] = ALPHA * __uint_as_float(xr.y << 16) + acc[ai][bj][m][0][2]; y[3] = ALPHA * __uint_as_float(xr.y & 0xffff0000u) + acc[ai][bj][m][0][3];
                    y[4] = ALPHA * __uint_as_float(xr.z << 16) + acc[ai][bj][m][1][0]; y[5] = ALPHA * __uint_as_float(xr.z & 0xffff0000u) + acc[ai][bj][m][1][1];
                    y[6] = ALPHA * __uint_as_float(xr.w << 16) + acc[ai][bj][m][1][2]; y[7] = ALPHA * __uint_as_float(xr.w & 0xffff0000u) + acc[ai][bj][m][1][3];
                    *(u32x4*)(Y + off + bj * 128) = __builtin_bit_cast(u32x4, cvt8(y));
#pragma unroll
                    for (int j = 0; j < 8; ++j) { s1 += y[j]; s2 += y[j] * y[j]; } }
                s1 = xadd32(xadd16(s1)); s2 = xadd32(xadd16(s2));
                if (fq == 0) *(f32x2*)(ystat + ((size_t)row * 64 + u.pn * 4 + wc) * 2) = (f32x2){s1, s2};
                asm volatile("" ::: "memory"); }
    }
};
constexpr int AT_STAGE = 65536, AT_K1 = 16384, AT_V = 32768, AT_TAB = 143360  , AT_XSTRIDE = 260;

__device__ __forceinline__ void attn_dma_offsets(unsigned (&ko)[2], unsigned (&vo)[2], int wid, int lane) {
#pragma unroll
    for (int j = 0; j < 2; ++j) { const int i = wid * 2 + j, row = 4 * i + (lane >> 4), gch = (lane & 15) ^ (row & 15);
        ko[j] = (unsigned)((row * SW + 8 * gch) * 2); }
#pragma unroll
    for (int j = 0; j < 2; ++j) { const int i = wid * 4 + j, row = 2 * i + (lane >> 5), gch = (lane & 31) ^ ((row & 3) << 2);
        vo[j] = (unsigned)((row * SW + 8 * gch) * 2); }
}
__device__ __forceinline__ void attn_issue_tile(LAS unsigned char* stage, __amdgpu_buffer_rsrc_t krs, __amdgpu_buffer_rsrc_t vrs, int soff, const unsigned (&ko)[2], const unsigned (&vo)[2], int wid) {
#pragma unroll
    for (int j = 0; j < 2; ++j) {
        __builtin_amdgcn_raw_ptr_buffer_load_lds(krs, (LAS unsigned*)(stage + (wid * 2 + j) * 1024), 16, ko[j], soff, 0, 0);
        __builtin_amdgcn_raw_ptr_buffer_load_lds(krs, (LAS unsigned*)(stage + AT_K1 + (wid * 2 + j) * 1024), 16, ko[j], soff + 256, 0, 0);
    }
#pragma unroll
    for (int j = 0; j < 4; ++j)
        __builtin_amdgcn_raw_ptr_buffer_load_lds(vrs, (LAS unsigned*)(stage + AT_V + (wid * 4 + j) * 1024), 16, vo[j & 1], soff + (j >> 1) * (4 * SW * 2), 0, 0);
}

__device__ __forceinline__ int crow(int reg, int h) { return (reg & 3) + 8 * (reg >> 2) + 4 * h; }
constexpr float AT_THR = 8.0f;

__device__ __forceinline__ void attn_unit(LAS unsigned char* lds, const bf16_t* Qb, const bf16_t* Kb, const bf16_t* Vb, bf16_t* AO,
                                          int b, int h, int qt, float lam, int tid, int wid, int lane_in) {
    int lane = lane_in; asm volatile("" : "+v"(lane));
    const int map = wid >> 2, wq = wid & 3, r = lane & 31, hh = lane >> 5;
    const int hcol = h * 256;
    const size_t seq0 = (size_t)b * SEQ;
    const int qpos = qt * 128 + wq * 32 + r;
    const LAS float* tab = (const LAS float*)(lds + AT_TAB) + 32;
    bf16x8 qf[8];
    { const bf16_t* qp = Qb + (seq0 + qpos) * SW + hcol + map * 128 + 8 * hh;
#pragma unroll
      for (int s = 0; s < 8; ++s) qf[s] = *(const bf16x8*)(qp + 16 * s); }
    const int ntiles = 2 * (qt + 1);
    f32x16 O[8];
#pragma unroll
    for (int c = 0; c < 8; ++c)
#pragma unroll
        for (int i = 0; i < 16; ++i) O[c][i] = 0.f;
    float m_run = NEG_BIG, l_run = 0.f;
    const float farb = tab[255];
    const int kx = r & 15;
    const int q4 = (lane & 15) >> 2, p4 = lane & 3, blk = (lane >> 4) & 1;
    int vb[4];
#pragma unroll
    for (int c1 = 0; c1 < 4; ++c1) vb[c1] = (4 * hh + q4) * 512 + 64 * (c1 ^ q4) + 32 * blk + 16 * (p4 >> 1) + 8 * (p4 & 1);
    unsigned ko[2], vo[2];
    attn_dma_offsets(ko, vo, wid, lane);
    const __amdgpu_buffer_rsrc_t krs = __builtin_amdgcn_make_buffer_rsrc((void*)Kb, 0, NTOK * SW * 2, 0x00020000);
    const __amdgpu_buffer_rsrc_t vrs = __builtin_amdgcn_make_buffer_rsrc((void*)Vb, 0, NTOK * SW * 2, 0x00020000);
    const int soff0 = (int)((seq0 * SW + hcol) * 2);
    constexpr int TILE_BYTES = 64 * SW * 2;

    attn_issue_tile(lds, krs, vrs, soff0, ko, vo, wid);
    asm volatile("s_waitcnt vmcnt(0)" ::: "memory");
    __syncthreads();
#pragma unroll 1
    for (int t = 0; t < ntiles; ++t) {
        LAS unsigned char* stage = lds + (t & 1) * AT_STAGE;
        if (t + 1 < ntiles) attn_issue_tile(lds + ((t + 1) & 1) * AT_STAGE, krs, vrs, soff0 + (t + 1) * TILE_BYTES, ko, vo, wid);
        const int kbase = 64 * t;
        const bool far = (qt * 128 + wq * 32 - (kbase + 63)) >= 128;
#pragma unroll
        for (int tt = 0; tt < 2; ++tt) {
            if (kbase + 32 * tt > qt * 128 + wq * 32 + 31) continue;
            const LAS unsigned char* kt = stage + map * AT_K1 + (32 * tt + r) * 256;
            f32x16 X;
#pragma unroll
            for (int i = 0; i < 16; ++i) X[i] = 0.f;
            { bf16x8 kf[8];
#pragma unroll
              for (int s = 0; s < 8; ++s) kf[s] = *(const LAS bf16x8*)(kt + 16 * ((2 * s + hh) ^ kx));
              __builtin_amdgcn_sched_barrier(0);
#pragma unroll
              for (int s = 0; s < 8; ++s) X = MFMA32(kf[s], qf[s], X); }
            if (far) {
#pragma unroll
                for (int i = 0; i < 16; ++i) X[i] += farb;
            } else {
                const LAS float* tp = tab + (qpos - (kbase + 32 * tt + 4 * hh));
#pragma unroll
                for (int i = 0; i < 16; ++i) X[i] += tp[-((i & 3) + 8 * (i >> 2))];
            }
            float mx = X[0];
#pragma unroll
            for (int i = 1; i < 16; ++i) mx = fmaxf(mx, X[i]);
            mx = xmax32(mx);
            const bool upd = mx > m_run + AT_THR;
            if (__any(upd)) {
                const float mnew = upd ? mx : m_run;
                const float alpha = __builtin_amdgcn_exp2f(m_run - mnew);
                m_run = mnew; l_run *= alpha;
#pragma unroll
                for (int c = 0; c < 8; ++c)
#pragma unroll
                    for (int i = 0; i < 16; ++i) O[c][i] *= alpha;
            }
            float ls = 0.f;
#pragma unroll
            for (int i = 0; i < 16; ++i) { X[i] = __builtin_amdgcn_exp2f(X[i] - m_run); ls += X[i]; }
            l_run += ls;
            bf16x8 pf[2];
#pragma unroll
            for (int s = 0; s < 2; ++s) {
                f32x8 a;
#pragma unroll
                for (int j = 0; j < 8; ++j) a[j] = X[8 * s + j];
                pf[s] = cvt8(a);
            }
            const LAS unsigned char* vt = stage + AT_V + (32 * tt) * 512;
#pragma unroll
            for (int s = 0; s < 2; ++s)
#pragma unroll
                for (int c = 0; c < 8; ++c) {
                    const int rowoff = (16 * s) * 512 + 256 * (c >> 2);
                    const s16x4 lo = __builtin_amdgcn_ds_read_tr16_b64_v4i16((LAS s16x4*)(vt + vb[c & 3] + rowoff));
                    const s16x4 hi = __builtin_amdgcn_ds_read_tr16_b64_v4i16((LAS s16x4*)(vt + vb[c & 3] + rowoff + 8 * 512));
                    const bf16x8 vf = __builtin_shufflevector(lo, hi, 0, 1, 2, 3, 4, 5, 6, 7);
                    O[c] = MFMA32(vf, pf[s], O[c]);
                }
        }
        asm volatile("s_waitcnt vmcnt(0)" ::: "memory");
        __syncthreads();
    }
    const float ltot = xadd32(l_run);
    const float inv = 1.0f / ltot;
    int lane_e = lane_in; asm volatile("" : "+v"(lane_e));
    const int r_e = lane_e & 31, hh_e = lane_e >> 5;
    LAS float* xb = (LAS float*)lds + (size_t)wq * (32 * AT_XSTRIDE) + r_e * AT_XSTRIDE + 4 * hh_e;
    if (map == 1) {
        const float sc = inv * lam;
#pragma unroll
        for (int c = 0; c < 8; ++c)
#pragma unroll
            for (int g = 0; g < 4; ++g) {
                f32x4 v = {O[c][4 * g] * sc, O[c][4 * g + 1] * sc, O[c][4 * g + 2] * sc, O[c][4 * g + 3] * sc};
                *(LAS f32x4*)(xb + 32 * c + 8 * g) = v;
            }
    }
    __syncthreads();
    if (map == 0) {
        float ss = 0.f;
#pragma unroll
        for (int c = 0; c < 8; ++c)
#pragma unroll
            for (int g = 0; g < 4; ++g) {
                const f32x4 o1 = *(const LAS f32x4*)(xb + 32 * c + 8 * g);
#pragma unroll
                for (int j = 0; j < 4; ++j) { const float d = O[c][4 * g + j] * inv - o1[j]; O[c][4 * g + j] = d; ss += d * d; }
                if (g == 3) asm volatile("" ::: "memory");
            }
        ss = xadd32(ss);
        const float rs = __builtin_amdgcn_rsqf(ss * (1.0f / 256.0f) + LN_EPS);
        bf16_t* op = AO + (seq0 + qt * 128 + wq * 32 + r_e) * DM + SW + hcol + 8 * hh_e;
#pragma unroll
        for (int c = 0; c < 8; ++c)
#pragma unroll
            for (int gp = 0; gp < 4; gp += 2) {
                const f32x4 va = {O[c][4 * gp] * rs, O[c][4 * gp + 1] * rs, O[c][4 * gp + 2] * rs, O[c][4 * gp + 3] * rs};
                const f32x4 vb_ = {O[c][4 * gp + 4] * rs, O[c][4 * gp + 5] * rs, O[c][4 * gp + 6] * rs, O[c][4 * gp + 7] * rs};
                const u32x2 a = __builtin_bit_cast(u32x2, cvt4(va)), b = __builtin_bit_cast(u32x2, cvt4(vb_));
                const auto s0 = __builtin_amdgcn_permlane32_swap(a.x, b.x, false, false);
                const auto s1 = __builtin_amdgcn_permlane32_swap(a.y, b.y, false, false);
                u32x4 o = {(unsigned)s0[0], (unsigned)s1[0], (unsigned)s0[1], (unsigned)s1[1]};
                *(u32x4*)(op + 32 * c + 8 * gp) = o;
            }
    }
    __syncthreads();
}

__device__ __forceinline__ void attn_phase(LAS unsigned char* lds, const float* const* in, unsigned char* ws, int vcu, int G, int tid, int wid, int lane) {
    const bf16_t* Qb = (const bf16_t*)(ws + WS_QKVUG); const bf16_t* Kb = Qb + (size_t)NTOK * SW; const bf16_t* Vb = Kb + (size_t)NTOK * SW;
    bf16_t* AO = (bf16_t*)(ws + WS_AO);
    float lam;
    { const float* q1 = in[3]; const float* k1 = in[4]; const float* q2 = in[5]; const float* k2 = in[6];
      float s1 = q1[lane] * k1[lane] + q1[lane + 64] * k1[lane + 64], s2 = q2[lane] * k2[lane] + q2[lane + 64] * k2[lane + 64];
      s1 = wave_sum(s1); s2 = wave_sum(s2); lam = __expf(s1) - __expf(s2) + LAMBDA_INIT; }
    const float* rel = in[14];
    int cur_h = -1;
    if (wid >= 4) __builtin_amdgcn_s_setprio(1);
    for (int p = vcu; p < 256; p += G) {
        const int bh = p >> 3, s = p & 7, b = bh >> 3, h = bh & 7;
        if (h != cur_h) {
            __syncthreads();
            int tid_o = tid; asm volatile("" : "+v"(tid_o));
            if (tid_o < 288) { const int n = tid_o - 32; int bucket;
                if (n < 16) bucket = n < 0 ? 0 : n; else { const int lg = 16 + (int)(logf((float)n * (1.0f / 16.0f)) / 2.0794415416798357f * 16.0f); bucket = lg < 31 ? lg : 31; }
                ((LAS float*)(lds + AT_TAB))[tid_o] = n < 0 ? NEG_BIG : rel[bucket * 8 + h] * LOG2E; }
            __syncthreads(); cur_h = h;
        }
        attn_unit(lds, Qb, Kb, Vb, AO, b, h, 15 - s, lam, tid, wid, lane);
        attn_unit(lds, Qb, Kb, Vb, AO, b, h, s, lam, tid, wid, lane);
    }
    __builtin_amdgcn_s_setprio(0);
}
constexpr int GM_STAT = 131072;
constexpr int GM_RED = 132096;
constexpr int GM_W = 65536;

__device__ __forceinline__ int gm_voff(int s, int c8) { return s * 512 + 16 * (c8 ^ (((s & 3) << 1) | (((s >> 3) & 1) << 3))); }

__device__ __forceinline__ void gmlp_unit(LAS unsigned char* lds, const float* const* in, unsigned char* ws, int b, int ch, int h, int tid_in, int wid, int lane_in) {
    int tid = tid_in; asm volatile("" : "+v"(tid)); const int lane = tid & 63;
    const bf16_t* U = (const bf16_t*)(ws + WS_QKVUG) + (size_t)3 * NTOK * SW; const bf16_t* GG = U + (size_t)NTOK * SW;
    const float* gstat = (const float*)(ws + WS_GSTAT);
    bf16_t* AO = (bf16_t*)(ws + WS_AO); float* gpart = (float*)(ws + WS_GPART);
    const float* ln_g = in[9]; const float* ln_b = in[10]; const float* spw = in[11]; const float* spb = in[12];
    const size_t R0 = (size_t)b * SEQ + (size_t)ch * 128;
    LAS float* st = (LAS float*)(lds + GM_STAT); LAS float* red = (LAS float*)(lds + GM_RED);
    __syncthreads();
    u32x4 raw_[8]; f32x4 wa[4], wb[4];
#pragma unroll
    for (int i = 0; i < 8; ++i) { const int idx = tid + 512 * i, s = idx >> 5, c8 = idx & 31; raw_[i] = *(const u32x4*)(GG + (R0 + s) * SW + h * 256 + 8 * c8); }
#pragma unroll
    for (int i = 0; i < 4; ++i) { const int idx = tid + 512 * i, t = idx >> 4, c = idx & 15; const float* wp = spw + ((size_t)h * 128 + t) * 128 + 8 * c; wa[i] = *(const f32x4*)wp; wb[i] = *(const f32x4*)(wp + 4); }
    { const int r = tid >> 2, sub = tid & 3;
      const f32x4* gp = (const f32x4*)(gstat + (R0 + r) * 64 + sub * 16);
      const f32x4 a0 = gp[0], a1 = gp[1], a2 = gp[2], a3 = gp[3];
      float s1 = ((a0[0] + a0[2]) + (a1[0] + a1[2])) + ((a2[0] + a2[2]) + (a3[0] + a3[2])), s2 = ((a0[1] + a0[3]) + (a1[1] + a1[3])) + ((a2[1] + a2[3]) + (a3[1] + a3[3]));
      s1 = xadd2(xadd1(s1)); s2 = xadd2(xadd1(s2));
      if (sub == 0) { const float mean = s1 * (1.0f / SW), var = fmaxf(s2 * (1.0f / SW) - mean * mean, 0.f);
          st[2 * r] = mean; st[2 * r + 1] = __builtin_amdgcn_rsqf(var + LN_EPS); } }
    __syncthreads();
    const int tl = lane & 15, g4 = lane >> 4, q4 = (lane & 15) >> 2, p4 = lane & 3;
#pragma unroll
    for (int i = 0; i < 8; ++i) {
        const int idx = tid + 512 * i, s = idx >> 5, c8 = idx & 31; const int col = h * 256 + 8 * c8;
        const u32x4 raw = raw_[i];
        const f32x4 ga = *(const f32x4*)(ln_g + col), gb = *(const f32x4*)(ln_g + col + 4), ba = *(const f32x4*)(ln_b + col), bb = *(const f32x4*)(ln_b + col + 4);
        const float mean = st[2 * s], rstd = st[2 * s + 1];
        f32x8 v;
        v[0] = (__uint_as_float(raw.x << 16) - mean) * rstd * ga[0] + ba[0]; v[1] = (__uint_as_float(raw.x & 0xffff0000u) - mean) * rstd * ga[1] + ba[1];
        v[2] = (__uint_as_float(raw.y << 16) - mean) * rstd * ga[2] + ba[2]; v[3] = (__uint_as_float(raw.y & 0xffff0000u) - mean) * rstd * ga[3] + ba[3];
        v[4] = (__uint_as_float(raw.z << 16) - mean) * rstd * gb[0] + bb[0]; v[5] = (__uint_as_float(raw.z & 0xffff0000u) - mean) * rstd * gb[1] + bb[1];
        v[6] = (__uint_as_float(raw.w << 16) - mean) * rstd * gb[2] + bb[2]; v[7] = (__uint_as_float(raw.w & 0xffff0000u) - mean) * rstd * gb[3] + bb[3];
        *(LAS bf16x8*)(lds + gm_voff(s, c8)) = cvt8(v);
    }
#pragma unroll
    for (int i = 0; i < 4; ++i) {
        const int idx = tid + 512 * i, t = idx >> 4, c = idx & 15;
        const f32x4 a = wa[i], b4 = wb[i];
        f32x8 w = {a[0], a[1], a[2], a[3], b4[0], b4[1], b4[2], b4[3]};
#pragma unroll
        for (int j = 0; j < 8; ++j) w[j] = (8 * c + j <= t) ? w[j] : 0.f;
        *(LAS bf16x8*)(lds + GM_W + t * 272 + 16 * c) = cvt8(w);
    }
    __syncthreads();
    f32x4 acc[8][2];
#pragma unroll
    for (int mt = 0; mt < 8; ++mt)
#pragma unroll
        for (int nl = 0; nl < 2; ++nl) acc[mt][nl] = (f32x4){0.f, 0.f, 0.f, 0.f};
    u32x2 ur[8][2]; float bsv[8];
#pragma unroll
    for (int mt = 0; mt < 8; ++mt) { const int t_in = 16 * mt + tl; bsv[mt] = spb[h * 128 + t_in];
#pragma unroll
        for (int nl = 0; nl < 2; ++nl) ur[mt][nl] = *(const u32x2*)(U + (R0 + t_in) * SW + h * 256 + 16 * (2 * wid + nl) + 4 * g4); }
    __builtin_amdgcn_sched_barrier(0);
#pragma unroll
    for (int ks = 0; ks < 4; ++ks) {
        bf16x8 vf[2];
#pragma unroll
        for (int nl = 0; nl < 2; ++nl) {
            const int c = 2 * wid + nl, r0 = 32 * ks + 8 * g4 + q4;
            const s16x4 lo = __builtin_amdgcn_ds_read_tr16_b64_v4i16((LAS s16x4*)(lds + gm_voff(r0, 2 * c + (p4 >> 1)) + 8 * (p4 & 1)));
            const s16x4 hi = __builtin_amdgcn_ds_read_tr16_b64_v4i16((LAS s16x4*)(lds + gm_voff(r0 + 4, 2 * c + (p4 >> 1)) + 8 * (p4 & 1)));
            vf[nl] = __builtin_shufflevector(lo, hi, 0, 1, 2, 3, 4, 5, 6, 7);
        }
#pragma unroll
        for (int mt = 2 * ks; mt < 8; ++mt) {
            const bf16x8 wf = *(const LAS bf16x8*)(lds + GM_W + (16 * mt + tl) * 272 + (32 * ks + 8 * g4) * 2);
#pragma unroll
            for (int nl = 0; nl < 2; ++nl) acc[mt][nl] = MFMA16(vf[nl], wf, acc[mt][nl]);
        }
    }
#pragma unroll
    for (int mt = 0; mt < 8; ++mt) {
        const int t_in = 16 * mt + tl; const float bs = bsv[mt]; float ssq = 0.f;
#pragma unroll
        for (int nl = 0; nl < 2; ++nl) {
            const int col = h * 256 + 16 * (2 * wid + nl) + 4 * g4;
            const u32x2 uq = ur[mt][nl];
            f32x4 g;
            g[0] = __uint_as_float(uq.x << 16) * (acc[mt][nl][0] + bs); g[1] = __uint_as_float(uq.x & 0xffff0000u) * (acc[mt][nl][1] + bs);
            g[2] = __uint_as_float(uq.y << 16) * (acc[mt][nl][2] + bs); g[3] = __uint_as_float(uq.y & 0xffff0000u) * (acc[mt][nl][3] + bs);
            ssq += (g[0] * g[0] + g[1] * g[1]) + (g[2] * g[2] + g[3] * g[3]);
            *(s16x4*)(AO + (R0 + t_in) * DM + col) = cvt4(g);
        }
        ssq = xadd32(xadd16(ssq));
        if (g4 == 0) red[wid * 128 + t_in] = ssq;
    }
    __syncthreads();
    if (tid < 128) { float tot = 0.f;
#pragma unroll
        for (int w = 0; w < 8; ++w) tot += red[w * 128 + tid];
        gpart[(R0 + tid) * 8 + h] = tot; }
}

__device__ __forceinline__ void gmlp_phase(LAS unsigned char* lds, const float* const* in, unsigned char* ws, int vcu, int G, int tid, int wid, int lane) {
    for (int u = vcu; u < 512; u += G) gmlp_unit(lds, in, ws, u >> 7, (u >> 3) & 15, u & 7, tid, wid, lane);
}
constexpr int RT_STAT = 0;
constexpr int RT_PART = 1024;
constexpr int RT_LOGIT = 1024 + 8 * 32 * 80 * 4;
constexpr int RT_GB = 98304;

__device__ __forceinline__ void route_unit(LAS unsigned char* lds, const float* const* in, float* zout, unsigned char* ws, int rgp, int tid, int wid, int lane) {
    const bf16_t* Y = (const bf16_t*)(ws + WS_Y); bf16_t* X1B = (bf16_t*)(ws + WS_X1B);
    const bf16_t* WRT = (const bf16_t*)(ws + WS_WRT);
    const float* g1 = in[15]; const float* b1 = in[16];
    LAS float* st = (LAS float*)(lds + RT_STAT); LAS float* part = (LAS float*)(lds + RT_PART); LAS float* logit = (LAS float*)(lds + RT_LOGIT);
    const int row0 = rgp * 32;
    __syncthreads();
    LAS f32x4* gl = (LAS f32x4*)(lds + RT_GB); LAS f32x4* bl = gl + DM / 4;
    { const f32x4 t0 = ((const f32x4*)g1)[tid], t1 = ((const f32x4*)g1)[tid + 512], t2 = ((const f32x4*)b1)[tid], t3 = ((const f32x4*)b1)[tid + 512];
      __builtin_amdgcn_sched_barrier(0);
      gl[tid] = t0; gl[tid + 512] = t1; bl[tid] = t2; bl[tid + 512] = t3; }
    { const float* ystat = (const float*)(ws + WS_YSTAT); const int r = tid >> 4, sub = tid & 15;
      const f32x4* yp = (const f32x4*)(ystat + ((size_t)(row0 + r) * 64 + sub * 4) * 2);
      const f32x4 a = yp[0], b = yp[1];
      float s1 = (a[0] + a[2]) + (b[0] + b[2]), s2 = (a[1] + a[3]) + (b[1] + b[3]);
      s1 = row_sum16(s1); s2 = row_sum16(s2);
      if (sub == 0) { const float mean = s1 * (1.0f / DM), var = fmaxf(s2 * (1.0f / DM) - mean * mean, 0.f); st[2 * r] = mean; st[2 * r + 1] = __builtin_amdgcn_rsqf(var + LN_EPS); } }
    __syncthreads();
    const int tl = lane & 15, g4 = lane >> 4;
    f32x4 acc[2][5];
#pragma unroll
    for (int mt = 0; mt < 2; ++mt)
#pragma unroll
        for (int nt = 0; nt < 5; ++nt) acc[mt][nt] = (f32x4){0.f, 0.f, 0.f, 0.f};
    float mean[2], rstd[2];
#pragma unroll
    for (int mt = 0; mt < 2; ++mt) { mean[mt] = st[2 * (16 * mt + tl)]; rstd[mt] = st[2 * (16 * mt + tl) + 1]; }
    struct KBuf { u32x4 y[2]; bf16x8 wh[5], wl[5]; };
    auto kload = [&](KBuf& B, int ks) {
        const unsigned lofs = (unsigned)((tl * DM + 512 * wid + 32 * ks + 8 * g4) * 2);
#pragma unroll
        for (int mt = 0; mt < 2; ++mt) B.y[mt] = *(const u32x4*)((const char*)(Y + (size_t)(row0 + 16 * mt) * DM) + lofs);
#pragma unroll
        for (int nt = 0; nt < 5; ++nt) { B.wh[nt] = *(const bf16x8*)((const char*)(WRT + (size_t)(16 * nt) * DM) + lofs); B.wl[nt] = *(const bf16x8*)((const char*)(WRT + (size_t)(80 + 16 * nt) * DM) + lofs); }
    };
    auto kcomp = [&](const KBuf& B, int ks) {
        const int k0 = 512 * wid + 32 * ks + 8 * g4;
        const f32x4 ga = gl[k0 >> 2], gb = gl[(k0 >> 2) + 1], ba = bl[k0 >> 2], bb = bl[(k0 >> 2) + 1];
        bf16x8 ah[2], al[2];
#pragma unroll
        for (int mt = 0; mt < 2; ++mt) {
            const u32x4 yr = B.y[mt];
            const f32x4 ya = {__uint_as_float(yr.x << 16), __uint_as_float(yr.x & 0xffff0000u), __uint_as_float(yr.y << 16), __uint_as_float(yr.y & 0xffff0000u)};
            const f32x4 yb = {__uint_as_float(yr.z << 16), __uint_as_float(yr.z & 0xffff0000u), __uint_as_float(yr.w << 16), __uint_as_float(yr.w & 0xffff0000u)};
            f32x8 x;
#pragma unroll
            for (int j = 0; j < 4; ++j) { x[j] = (ya[j] - mean[mt]) * rstd[mt] * ga[j] + ba[j]; x[4 + j] = (yb[j] - mean[mt]) * rstd[mt] * gb[j] + bb[j]; }
            const bf16x8 hi = cvt8(x); ah[mt] = hi;
            f32x8 lo;
#pragma unroll
            for (int j = 0; j < 8; ++j) lo[j] = x[j] - __uint_as_float(((unsigned)(unsigned short)hi[j]) << 16);
            al[mt] = cvt8(lo);
        }
#pragma unroll
        for (int nt = 0; nt < 5; ++nt)
#pragma unroll
            for (int mt = 0; mt < 2; ++mt) { acc[mt][nt] = MFMA16(ah[mt], B.wh[nt], acc[mt][nt]); acc[mt][nt] = MFMA16(ah[mt], B.wl[nt], acc[mt][nt]); acc[mt][nt] = MFMA16(al[mt], B.wh[nt], acc[mt][nt]); }
#pragma unroll
        for (int mt = 0; mt < 2; ++mt) *(bf16x8*)((char*)(X1B + (size_t)(row0 + 16 * mt) * DM) + (unsigned)((tl * DM + k0) * 2)) = ah[mt];
    };
    KBuf kb0, kb1;
    kload(kb0, 0);
#pragma unroll 1
    for (int kp = 0; kp < 8; ++kp) {
        kload(kb1, 2 * kp + 1); __builtin_amdgcn_sched_barrier(0);
        kcomp(kb0, 2 * kp); __builtin_amdgcn_sched_barrier(0);
        if (kp + 1 < 8) kload(kb0, 2 * kp + 2);
        __builtin_amdgcn_sched_barrier(0);
        kcomp(kb1, 2 * kp + 1); __builtin_amdgcn_sched_barrier(0);
    }
#pragma unroll
    for (int mt = 0; mt < 2; ++mt)
#pragma unroll
        for (int nt = 0; nt < 5; ++nt)
#pragma unroll
            for (int i = 0; i < 4; ++i) part[(wid * 32 + 16 * mt + 4 * g4 + i) * 80 + 16 * nt + tl] = acc[mt][nt][i];
    __syncthreads();
    for (int idx = tid; idx < 32 * 80; idx += 512) { float s = 0.f;
#pragma unroll
        for (int w = 0; w < 8; ++w) s += part[w * 2560 + idx];
        logit[idx] = s; }
    __syncthreads();
    if (tid < 32) {
        const float* bg = in[18]; const float* be = in[20];
        const LAS float* lg = logit + tid * 80;
        float gl[8]; int gi = 0; float gm = -3.0e38f;
#pragma unroll
        for (int j = 0; j < 8; ++j) { gl[j] = lg[j] + bg[j]; if (gl[j] > gm) { gm = gl[j]; gi = j; } }
        float den = 0.f;
#pragma unroll
        for (int j = 0; j < 8; ++j) den += __expf(gl[j] - gm);
        const float gw = 1.0f / den;
        float t1 = -3.0e38f, t2 = -3.0e38f; int i1 = 0, i2 = 0;
        const f32x4 be0 = *(const f32x4*)(be + 8 * gi), be1 = *(const f32x4*)(be + 8 * gi + 4);
        const float bev[8] = {be0[0], be0[1], be0[2], be0[3], be1[0], be1[1], be1[2], be1[3]};
#pragma unroll
        for (int j = 0; j < 8; ++j) { const float v = lg[8 + 8 * gi + j] + bev[j];
            if (v > t1) { t2 = t1; i2 = i1; t1 = v; i1 = j; } else if (v > t2) { t2 = v; i2 = j; } }
        const float e2 = __expf(t2 - t1), w1 = 1.0f / (1.0f + e2), w2 = e2 * w1;
        const int token = row0 + tid, e0 = 8 * gi + i1, e1 = 8 * gi + i2;
        unsigned* cnt = (unsigned*)(ws + WS_CTL) + CW_CNT;
        int* tokl = (int*)(ws + WS_TOKL); float* wl = (float*)(ws + WS_WL);
        const int p0 = (int)atomicAdd(cnt + 32 * e0, 1u), p1 = (int)atomicAdd(cnt + 32 * e1, 1u);
        tokl[e0 * NTOK + p0] = token; wl[e0 * NTOK + p0] = gw * w1;
        tokl[e1 * NTOK + p1] = token; wl[e1 * NTOK + p1] = gw * w2;
        ((i32x4*)(ws + WS_ROUTE))[token] = (i32x4){e0, p0, e1, p1};
    }
}

namespace egC {
#ifndef EG_WAUX
#define EG_WAUX 2
#endif
constexpr int EG_ROWS = 320, EG_MT = EG_ROWS / 16;
constexpr int EG_NW = 4, EG_PFW = 3, EG_UNR = 4, EG_WSTG = 16384, EG_ASTG = EG_ROWS * 128;
constexpr int EG_AOFF = EG_NW * EG_WSTG, EG_WLOFF = EG_AOFF + 2 * EG_ASTG, EG_CNTOFF = EG_WLOFF + EG_ROWS * 4;
static_assert(EG_CNTOFF + 768 <= MISC_OFF && EG_UNR % EG_NW == 0 && EG_PFW == EG_NW - 1, "expert GEMM LDS map / ring geometry");

template <int MODE>
__device__ __forceinline__ void eg_unit(LAS unsigned char* lds, const float* const* in, unsigned char* ws, int e, int ugrp, int cnt, int base, int tid_in, int wid, int lane_in) {
    constexpr int K = MODE == 0 ? DM : DFF, LDB = MODE == 0 ? DFF : DM, KST = K / 32, NTG = MODE == 0 ? 1 : 2, TS = KST * NTG;
    constexpr int WROW = MODE == 0 ? 256 : 512;
    int lane; asm volatile("v_mbcnt_lo_u32_b32 %0, -1, 0\n\tv_mbcnt_hi_u32_b32 %0, -1, %0" : "=v"(lane));
    const int tid = wid * 64 + lane;
    bf16_t* H = (bf16_t*)(ws + WS_H); unsigned char* YS = ws + WS_YS;
    const int* tokl = (const int*)(ws + WS_TOKL) + (size_t)e * NTOK; const float* wlst = (const float*)(ws + WS_WL) + (size_t)e * NTOK;
    const int tl = lane & 15, g4 = lane >> 4;
    const bool consumer = wid < 4, wloader = (wid == 4 || wid == 5);
    const int cg = wid & 1, rh = (wid >> 1) & 1;
    const int wl = wid & 1, al = wid & 1;
    const float* wm0 = (MODE == 0 ? in[21] : in[23]) + (size_t)e * DM * DFF; const float* wm1 = (MODE == 0 ? in[22] : in[23]) + (size_t)e * DM * DFF;
    const __amdgpu_buffer_rsrc_t wrs0 = __builtin_amdgcn_make_buffer_rsrc((void*)wm0, 0, DM * DFF * 4, 0x00020000);
    const __amdgpu_buffer_rsrc_t wrs1 = __builtin_amdgcn_make_buffer_rsrc((void*)wm1, 0, DM * DFF * 4, 0x00020000);
    unsigned wvo[2];
#pragma unroll
    for (int x = 0; x < 2; ++x) wvo[x] = MODE == 0 ? (unsigned)((((16 * wl + (lane >> 4)) * LDB) + 4 * ((lane & 15) ^ x)) * 4) : (unsigned)((((16 * wl + (lane >> 5)) * LDB) + 4 * (((lane & 31) ^ (2 * (((lane & 31) >> 3) & 1))) ^ x)) * 4);
    const __amdgpu_buffer_rsrc_t ars = __builtin_amdgcn_make_buffer_rsrc(MODE == 0 ? (void*)(ws + WS_X1B) : (void*)(ws + WS_H), 0, MODE == 0 ? NTOK * DM * 2 : 2 * NTOK * DFF * 2, 0x00020000);
    int wfo[4];
#pragma unroll
    for (int t = 0; t < 4; ++t) { const int chunk = MODE == 0 ? 8 * cg + 2 * (tl >> 2) + (t & 1) : 16 * cg + 4 * (tl >> 2) + t;
        const int cpos = MODE == 0 ? chunk : (chunk ^ (2 * ((chunk >> 3) & 1)));
        wfo[t] = (MODE == 0 ? (t >> 1) * 8192 : 0) + (8 * g4) * WROW + 16 * (cpos ^ (g4 & 1)) + 4 * (tl & 3); }
    const int aoff0 = EG_AOFF + rh * 2048 + tl * 128 + 16 * (g4 ^ (tl & 7)), aoff1 = EG_AOFF + rh * 2048 + tl * 128 + 16 * ((4 + g4) ^ (tl & 7));
    LAS float* wl_lds = (LAS float*)(lds + EG_WLOFF);

    for (int rowp = 0; rowp < cnt; rowp += EG_ROWS) {
        const int nrows = (cnt - rowp) < EG_ROWS ? (cnt - rowp) : EG_ROWS, n_mt = (nrows + 15) >> 4;
        const int n_act = n_mt > rh ? (n_mt - rh + 1) >> 1 : 0;
        const int npc_ = (nrows - 160 * al + 7) >> 3; const int npc = npc_ < 0 ? 0 : (npc_ > 20 ? 20 : npc_);
        __syncthreads();
        if (MODE == 1) { if (tid < EG_ROWS) wl_lds[tid] = tid < nrows ? wlst[rowp + tid] : 0.f; }
        f32x4 acc[4][EG_MT / 2];
#define EG_STEP_BARRIER() do { __builtin_amdgcn_s_barrier(); asm volatile("" ::: "memory"); } while (0)
        if (wloader) {
#define EG_ISSUE_W(s_) do { const int s__ = (s_) < TS ? (s_) : TS - 1; LAS unsigned char* st_ = lds + ((s_) % EG_NW) * EG_WSTG; \
        if (MODE == 0) { const int so_ = ((s__ % KST) * 32 * LDB + ugrp * 64) * 4; \
            _Pragma("unroll") for (int jj = 0; jj < 4; ++jj) { \
                __builtin_amdgcn_raw_ptr_buffer_load_lds(wrs0, (LAS unsigned*)(st_ + (4 * wl + jj) * 1024), 16, wvo[(jj >> 1) & 1], so_ + jj * (4 * LDB * 4), 0, EG_WAUX); \
                __builtin_amdgcn_raw_ptr_buffer_load_lds(wrs1, (LAS unsigned*)(st_ + 8192 + (4 * wl + jj) * 1024), 16, wvo[(jj >> 1) & 1], so_ + jj * (4 * LDB * 4), 0, EG_WAUX); } } \
        else { const int so_ = ((s__ % KST) * 32 * LDB + ugrp * (NTG * 128) + (s__ / KST) * 128) * 4; \
            _Pragma("unroll") for (int jj = 0; jj < 8; ++jj) __builtin_amdgcn_raw_ptr_buffer_load_lds(wrs0, (LAS unsigned*)(st_ + (8 * wl + jj) * 1024), 16, wvo[(jj >> 2) & 1], so_ + jj * (2 * LDB * 4), 0, EG_WAUX); } } while (0)
            asm volatile("s_waitcnt vmcnt(0) lgkmcnt(0)" ::: "memory");
#pragma unroll
            for (int u = 0; u < EG_PFW; ++u) EG_ISSUE_W(u);
            asm volatile("s_waitcnt vmcnt(%0)" :: "n"(8 * (EG_PFW - 1)) : "memory");
            EG_STEP_BARRIER();
#pragma unroll 1
            for (int s = 0; s < TS; ++s) {
                EG_ISSUE_W(s + EG_PFW);
                asm volatile("s_waitcnt vmcnt(%0)" :: "n"(8 * (EG_PFW - 1)) : "memory");
                EG_STEP_BARRIER();
            }
#undef EG_ISSUE_W
        } else if (!consumer) {
            unsigned avo[20];
#pragma unroll
            for (int jj = 0; jj < 20; ++jj) { const int lr = 160 * al + 8 * jj + (lane >> 3); const int lrc = lr < nrows ? lr : 0;
                const unsigned ro = MODE == 0 ? (unsigned)tokl[rowp + lrc] * (DM * 2) : (unsigned)(base + rowp + lrc) * (DFF * 2);
                avo[jj] = ro + 16 * ((lane & 7) ^ ((lane >> 3) & 7)); }
            asm volatile("s_waitcnt vmcnt(0) lgkmcnt(0)" ::: "memory");
#define EG_ISSUE_A(j_) do { LAS unsigned char* st_ = lds + EG_AOFF + ((j_) & 1) * EG_ASTG + (20 * al) * 1024; const int so_ = ((j_) % (KST / 2)) * 128; \
        _Pragma("unroll") for (int jj = 0; jj < 20; ++jj) if (jj < npc) __builtin_amdgcn_raw_ptr_buffer_load_lds(ars, (LAS unsigned*)(st_ + jj * 1024), 16, avo[jj], so_, 0, 0); } while (0)
            EG_ISSUE_A(0);
            asm volatile("s_waitcnt vmcnt(0)" ::: "memory");
            EG_STEP_BARRIER();
#pragma unroll 1
            for (int s = 0; s < TS; s += 2) {
                if ((s >> 1) + 1 < TS / 2) EG_ISSUE_A((s >> 1) + 1);
                EG_STEP_BARRIER();
                asm volatile("s_waitcnt vmcnt(0)" ::: "memory");
                EG_STEP_BARRIER();
            }
#undef EG_ISSUE_A
        } else {
#pragma unroll
            for (int t = 0; t < 4; ++t)
#pragma unroll
                for (int i = 0; i < EG_MT / 2; ++i) acc[t][i] = (f32x4){0.f, 0.f, 0.f, 0.f};
            __builtin_amdgcn_s_waitcnt(0x0070);
            asm volatile("" ::: "memory");
            EG_STEP_BARRIER();
#pragma unroll 1
            for (int s0 = 0; s0 < TS; s0 += EG_UNR) {
#pragma unroll
                for (int u = 0; u < EG_UNR; ++u) {
                    const int s = s0 + u;
                    const LAS unsigned char* wsb = lds + (u % EG_NW) * EG_WSTG;
                    bf16x8 wf[4];
#pragma unroll
                    for (int t = 0; t < 4; ++t) { f32x8 wv;
#pragma unroll
                        for (int j = 0; j < 8; ++j) wv[j] = *(const LAS float*)(wsb + wfo[t] + j * WROW);
                        wf[t] = cvt8(wv); }
                    const LAS unsigned char* ab = lds + ((u >> 1) & 1) * EG_ASTG + ((u & 1) ? aoff1 : aoff0);
                    bf16x8 xf[2][2];
#pragma unroll
                    for (int q = 0; q < 2; ++q) xf[0][q] = *(const LAS bf16x8*)(ab + q * 4096);
#pragma unroll
                    for (int gq = 0; gq < EG_MT / 4; ++gq) {
                        if (gq + 1 < EG_MT / 4) { if (2 * (gq + 1) < n_act) {
#pragma unroll
                            for (int q = 0; q < 2; ++q) xf[(gq + 1) & 1][q] = *(const LAS bf16x8*)(ab + (2 * (gq + 1) + q) * 4096); } }
                        __builtin_amdgcn_sched_barrier(0);
                        if (2 * gq < n_act) {
#pragma unroll
                            for (int q = 0; q < 2; ++q)
#pragma unroll
                                for (int t = 0; t < 4; ++t) acc[t][2 * gq + q] = MFMA16(wf[t], xf[gq & 1][q], acc[t][2 * gq + q]); }
                        __builtin_amdgcn_sched_barrier(0);
                    }
                    if (MODE == 1) { if ((s % KST) == KST - 1) {
                        const int col = ugrp * (NTG * 128) + (s / KST) * 128 + 64 * cg + 16 * g4;
                        int tlo = tl; asm volatile("" : "+v"(tlo));
                        float wgv[EG_MT / 2];
#pragma unroll
                        for (int j = 0; j < EG_MT / 2; ++j) wgv[j] = wl_lds[16 * (2 * j + rh) + tlo];
#pragma unroll
                        for (int j = 0; j < EG_MT / 2; ++j) { if (j < n_act) { const int lr = 16 * (2 * j + rh) + tlo; const float wgt = wgv[j] * YS_SCALE;
                                u32x4 o;
#pragma unroll
                                for (int t = 0; t < 4; ++t) { const f32x4 a = acc[t][j] * wgt; int pk = 0;
                                    pk = __builtin_amdgcn_cvt_pk_fp8_f32(__builtin_amdgcn_fmed3f(a[0], -448.f, 448.f), __builtin_amdgcn_fmed3f(a[1], -448.f, 448.f), pk, false);
                                    pk = __builtin_amdgcn_cvt_pk_fp8_f32(__builtin_amdgcn_fmed3f(a[2], -448.f, 448.f), __builtin_amdgcn_fmed3f(a[3], -448.f, 448.f), pk, true);
                                    o[t] = (unsigned)pk; }
                                if (lr < nrows) *(u32x4*)(YS + (size_t)(base + rowp + lr) * DM + col) = o; }
#pragma unroll
                            for (int t = 0; t < 4; ++t) acc[t][j] = (f32x4){0.f, 0.f, 0.f, 0.f}; } } }
                    asm volatile("s_waitcnt lgkmcnt(0)" ::: "memory");
                    EG_STEP_BARRIER();
                }
            }
            if (MODE == 0) {
            const int col = ugrp * 64 + 32 * cg + 8 * g4;
#pragma unroll
            for (int j = 0; j < EG_MT / 2; ++j) if (j < n_act) { const int lr = 16 * (2 * j + rh) + tl;
                if (lr < nrows) { f32x8 hv;
#pragma unroll
                    for (int hf = 0; hf < 2; ++hf)
#pragma unroll
                        for (int i = 0; i < 4; ++i) { const float v = acc[hf][j][i]; hv[4 * hf + i] = v * __builtin_amdgcn_rcpf(1.0f + __expf(-v)) * acc[2 + hf][j][i]; }
                    *(bf16x8*)(H + (size_t)(base + rowp + lr) * DFF + col) = cvt8(hv); } }
            }
        }
#undef EG_STEP_BARRIER
        asm volatile("s_waitcnt vmcnt(0)" ::: "memory");
        __syncthreads();
#undef EG_ISSUE_W
#undef EG_ISSUE_A
    }
}

template <int MODE>
__device__ __forceinline__ void eg_phase(LAS unsigned char* lds, const float* const* in, unsigned char* ws, int vcu, int G, int tid, int wid, int lane, bool have) {
    LAS int* ecnt = (LAS int*)(lds + EG_CNTOFF); LAS int* ebase = ecnt + 64;
    LAS int* eord = ebase + 64;
    if (!have) {
    __syncthreads();
    if (tid < 64) { const unsigned* cnt = (const unsigned*)(ws + WS_CTL) + CW_CNT; int c = (int)cnt[32 * tid]; ecnt[tid] = c; }
    __syncthreads();
    if (tid < 64) { int s = 0; for (int j = 0; j < tid; ++j) s += ecnt[j]; ebase[tid] = s; }
    __syncthreads();
    if (tid < 64) { const int c = ecnt[tid]; int r = 0;
        for (int j = 0; j < 64; ++j) { const int cj = ecnt[j]; r += (cj > c || (cj == c && j < tid)) ? 1 : 0; }
        eord[r] = tid; }
    __syncthreads();
    }
    if (G == 256 && MODE == 0) {
        for (int k = 0; k < 2; ++k) { const int e = __builtin_amdgcn_readfirstlane(eord[k == 0 ? (vcu >> 3) : 63 - (vcu >> 3)]), ug = vcu & 7; const int c = __builtin_amdgcn_readfirstlane(ecnt[e]); if (c > 0) eg_unit<MODE>(lds, in, ws, e, ug, c, __builtin_amdgcn_readfirstlane(ebase[e]), tid, wid, lane); }
    } else if (G == 256) {
        for (int k = 0; k < 4; ++k) { const int i = vcu >> 4, ug = vcu & 15; const int e = __builtin_amdgcn_readfirstlane(eord[k == 0 ? i : (k == 1 ? 63 - i : (k == 2 ? 31 - i : 32 + i))]); const int c = __builtin_amdgcn_readfirstlane(ecnt[e]); if (c > 0) eg_unit<MODE>(lds, in, ws, e, ug, c, __builtin_amdgcn_readfirstlane(ebase[e]), tid, wid, lane); }
    } else {
        constexpr int NU = MODE == 0 ? 8 : 16;
        for (int u = vcu; u < NEXP * NU; u += G) { const int e = u / NU, ug = u % NU; const int c = __builtin_amdgcn_readfirstlane(ecnt[e]); if (c > 0) eg_unit<MODE>(lds, in, ws, e, ug, c, __builtin_amdgcn_readfirstlane(ebase[e]), tid, wid, lane); }
    }
}
}
constexpr int EG_CNTOFF = egC::EG_CNTOFF;
__device__ __forceinline__ void final_phase(LAS unsigned char* lds, const float* const* in, float* out, unsigned char* ws, int vcu, int G, int tid, int wid, int lane, bool have) {
    LAS int* ecnt = (LAS int*)(lds + EG_CNTOFF); LAS int* ebase = ecnt + 64;
    if (!have) {
    __syncthreads();
    if (tid < 64) { const unsigned* cnt = (const unsigned*)(ws + WS_CTL) + CW_CNT; ecnt[tid] = (int)cnt[32 * tid]; }
    __syncthreads();
    if (tid < 64) { int s = 0; for (int j = 0; j < tid; ++j) s += ecnt[j]; ebase[tid] = s; }
    __syncthreads();
    }
    const unsigned char* YS = ws + WS_YS; const bf16_t* X1B = (const bf16_t*)(ws + WS_X1B);
    LAS f32x4* g2l = (LAS f32x4*)lds; LAS f32x4* b2l = g2l + DM / 4;
    { const f32x4* g2 = (const f32x4*)in[24]; const f32x4* b2 = (const f32x4*)in[25];
      const f32x4 t0 = g2[tid], t1 = g2[tid + 512], t2 = b2[tid], t3 = b2[tid + 512];
      __builtin_amdgcn_sched_barrier(0);
      g2l[tid] = t0; g2l[tid + 512] = t1; b2l[tid] = t2; b2l[tid + 512] = t3;
      __syncthreads(); }
    const int stride = G * 8;
    int row = vcu * 8 + wid;
    i32x4 rt = {0, 0, 0, 0};
    u32x2 zr[16]; unsigned pr[16], qr[16];
    if (row < NTOK) { rt = ((const i32x4*)(ws + WS_ROUTE))[row]; const u32x2* xp0 = (const u32x2*)(X1B + (size_t)row * DM) + lane;
#pragma unroll
        for (int j = 0; j < 16; ++j) zr[j] = xp0[64 * j];
        const unsigned* y0 = (const unsigned*)(YS + (size_t)(ebase[rt[0]] + rt[1]) * DM) + lane; const unsigned* y1 = (const unsigned*)(YS + (size_t)(ebase[rt[2]] + rt[3]) * DM) + lane;
#pragma unroll
        for (int j = 0; j < 16; ++j) { pr[j] = y0[64 * j]; qr[j] = y1[64 * j]; } }
    i32x4 rtn = {0, 0, 0, 0};
    if (row + stride < NTOK) rtn = ((const i32x4*)(ws + WS_ROUTE))[row + stride];
#pragma unroll 1
    for (; row < NTOK; row += stride) {
        const int rown = row + stride; i32x4 rtnn = {0, 0, 0, 0};
        if (rown + stride < NTOK) rtnn = ((const i32x4*)(ws + WS_ROUTE))[rown + stride];
        f32x4* zp = (f32x4*)(out + (size_t)row * DM) + lane;
        f32x4 v[16]; float s = 0.f;
#pragma unroll
        for (int j = 0; j < 16; ++j) { const u32x2 z = zr[j]; const int p = (int)pr[j], q = (int)qr[j];
            v[j][0] = ALPHA * __uint_as_float(z.x << 16) + (__builtin_amdgcn_cvt_f32_fp8(p, 0) + __builtin_amdgcn_cvt_f32_fp8(q, 0)) * (1.0f / YS_SCALE);
            v[j][1] = ALPHA * __uint_as_float(z.x & 0xffff0000u) + (__builtin_amdgcn_cvt_f32_fp8(p, 1) + __builtin_amdgcn_cvt_f32_fp8(q, 1)) * (1.0f / YS_SCALE);
            v[j][2] = ALPHA * __uint_as_float(z.y << 16) + (__builtin_amdgcn_cvt_f32_fp8(p, 2) + __builtin_amdgcn_cvt_f32_fp8(q, 2)) * (1.0f / YS_SCALE);
            v[j][3] = ALPHA * __uint_as_float(z.y & 0xffff0000u) + (__builtin_amdgcn_cvt_f32_fp8(p, 3) + __builtin_amdgcn_cvt_f32_fp8(q, 3)) * (1.0f / YS_SCALE);
            s += (v[j][0] + v[j][1]) + (v[j][2] + v[j][3]); }
        if (rown < NTOK) { const u32x2* xpn = (const u32x2*)(X1B + (size_t)rown * DM) + lane;
#pragma unroll
            for (int j = 0; j < 16; ++j) zr[j] = xpn[64 * j];
            const unsigned* y0 = (const unsigned*)(YS + (size_t)(ebase[rtn[0]] + rtn[1]) * DM) + lane; const unsigned* y1 = (const unsigned*)(YS + (size_t)(ebase[rtn[2]] + rtn[3]) * DM) + lane;
#pragma unroll
            for (int j = 0; j < 16; ++j) { pr[j] = y0[64 * j]; qr[j] = y1[64 * j]; } }
        const float mean = wave_sum(s) * (1.0f / DM); float q2 = 0.f;
#pragma unroll
        for (int j = 0; j < 16; ++j) { v[j] = v[j] - mean; q2 += (v[j][0] * v[j][0] + v[j][1] * v[j][1]) + (v[j][2] * v[j][2] + v[j][3] * v[j][3]); }
        const float rstd = __builtin_amdgcn_rsqf(wave_sum(q2) * (1.0f / DM) + LN_EPS);
        int lo_ = lane; asm volatile("" : "+v"(lo_));
#pragma unroll
        for (int j = 0; j < 16; ++j) { const f32x4 gg = g2l[64 * j + lo_], bb = b2l[64 * j + lo_]; zp[64 * j] = v[j] * rstd * gg + bb; }
        rtn = rtnn;
    }
}
#ifndef MK_N_LAUNCHES
#define MK_N_LAUNCHES 1
#endif
#ifndef MK_P1_ALIGN
#define MK_P1_ALIGN true
#endif
#ifndef MK_P1_SP2
#define MK_P1_SP2 true
#endif
#ifndef MK_P3_ALIGN
#define MK_P3_ALIGN true
#endif
#ifndef MK_P3_SP2
#define MK_P3_SP2 true
#endif
constexpr int N_PHASES = 8;
struct Args { const float* in[26]; float* out; unsigned char* ws; int ph_lo, ph_hi, sub, pad; };

__global__ void __launch_bounds__(512, 2) mk_fwd(Args args) {
    extern __shared__ __attribute__((aligned(16))) unsigned char lds_raw[];
    LAS unsigned char* lds = (LAS unsigned char*)lds_raw;
    const int wid = __builtin_amdgcn_readfirstlane(threadIdx.x >> 6);
#define FRESH_TID() int lane; asm volatile("v_mbcnt_lo_u32_b32 %0, -1, 0\n\tv_mbcnt_hi_u32_b32 %0, -1, %0" : "=v"(lane)); const int tid = wid * 64 + lane;
    const int G = gridDim.x, bx = blockIdx.x;
    const int vcu = (G % 8 == 0) ? (bx % 8) * (G / 8) + bx / 8 : bx;
    unsigned char* ws = args.ws;
    unsigned* ctl = (unsigned*)(ws + WS_CTL);
    volatile LAS unsigned* MISC = (volatile LAS unsigned*)(lds + MISC_OFF);
    { FRESH_TID(); if (tid < 32) MISC[tid] = 0u; }
    __syncthreads();
    const int lo = args.ph_lo, hi = args.ph_hi;
    XcdBarrier bar; bar.bar = ctl + CW_BAR + lo * XCD_BAR_WORDS; bar.x = 0; bar.st = MISC + 8; bar.w = (unsigned)wid;
    if (hi - lo > 1) bar = xcd_barrier_post(ctl + CW_BAR + lo * XCD_BAR_WORDS, MISC + 8);
#if MK_N_LAUNCHES == 1
#define MK_SUBARG 0
#else
#define MK_SUBARG args.sub
#endif
#ifndef MK_PHASE_MASK
#define MK_PHASE_MASK 255
#endif
#define IN(k) ((((MK_PHASE_MASK) >> (k)) & 1) && lo <= (k) && (k) < hi)
#define SEAM(k) do { if (IN(k) && IN((k) + 1)) xcd_barrier(bar); } while (0)
#ifndef MK_DUP
#define MK_DUP -1
#endif
#define REP(k) for (int rep_ = 0; rep_ < ((MK_DUP) == (k) ? 2 : 1); ++rep_)

    if (IN(0)) REP(0) { FRESH_TID(); p0_prologue(lds, args.in, ws, vcu, G, tid, wid, lane); }
    SEAM(0);
    if (IN(1)) REP(1) {
        pg8::Gemm g{(const bf16_t*)(ws + WS_XB), (const bf16_t*)(ws + WS_WINT), NTOK, DIN, DM};
        pg8::StaticOrder S; S.init(NTOK, DIN, G, bx);
        EpiProj E{(bf16_t*)(ws + WS_QKVUG), (float*)(ws + WS_GSTAT)};
        pg8::gemm_phase<EpiProj, pg8::StaticOrder, MK_P1_ALIGN, MK_P1_SP2>(lds, g, S, E, wid);
    }
    SEAM(1);
    if (IN(2)) {
#ifndef MK_P2_SUB
#define MK_P2_SUB 3
#endif
        if ((MK_P2_SUB & 1) && !(MK_SUBARG & 1)) REP(2) { FRESH_TID(); attn_phase(lds, args.in, ws, vcu, G, tid, wid, lane); }
        if ((MK_P2_SUB & 2) && !(MK_SUBARG & 2)) REP(20) { FRESH_TID(); gmlp_phase(lds, args.in, ws, vcu, G, tid, wid, lane); }
    }
    SEAM(2);
    if (IN(3)) REP(3) {
        pg8::Gemm g{(const bf16_t*)(ws + WS_AO), (const bf16_t*)(ws + WS_WOUTT), NTOK, DM, DM};
        pg8::StaticOrder S; S.init(NTOK, DM, G, bx);
        LAS float* rst = (LAS float*)(lds + 131072);
        { FRESH_TID();
#pragma unroll 1
          for (int p = 0; p < 2; ++p) { const int pmq = S.row_panel(2 * p + (wid >> 2));
              if (pmq >= 0) { const float* gp = (const float*)(ws + WS_GPART) + ((size_t)pmq * 256 + (tid & 255)) * 8; const f32x4 a = *(const f32x4*)gp, b = *(const f32x4*)(gp + 4);
                  rst[512 * p + tid] = __builtin_amdgcn_rsqf(((a[0] + a[1]) + (a[2] + a[3]) + (b[0] + b[1]) + (b[2] + b[3])) * (1.0f / SW) + LN_EPS); }
              if (S.row_panel(2 * p + 2) < 0) break; }
          __syncthreads(); }
        EpiY E{(const bf16_t*)(ws + WS_XB), (bf16_t*)(ws + WS_Y), (float*)(ws + WS_YSTAT), (const float*)(ws + WS_GPART), rst};
        pg8::gemm_phase<EpiY, pg8::StaticOrder, MK_P3_ALIGN, MK_P3_SP2>(lds, g, S, E, wid);
    }
    SEAM(3);
    if (IN(4)) { FRESH_TID(); for (int rgp = vcu; rgp < NTOK / 32; rgp += G) route_unit(lds, args.in, args.out, ws, rgp, tid, wid, lane); }
    SEAM(4);
    if (IN(5)) REP(5) { FRESH_TID(); egC::eg_phase<0>(lds, args.in, ws, vcu, G, tid, wid, lane, false); }
    SEAM(5);
    if (IN(6)) REP(6) { FRESH_TID(); egC::eg_phase<1>(lds, args.in, ws, vcu, G, tid, wid, lane, IN(5)); }
    SEAM(6);
    if (IN(7)) { FRESH_TID(); final_phase(lds, args.in, args.out, ws, vcu, G, tid, wid, lane, IN(5) || IN(6)); }
#undef IN
#undef SEAM
}
}

extern "C" void kernel_launch(void* const* d_in, const int* in_sizes, int n_in, void* d_out, int out_size, void* d_ws, size_t ws_size, hipStream_t stream) {
    using namespace mk;
    static int grid = 0;
    if (grid == 0) {
        if (n_in != 26 || out_size != NTOK * DM || ws_size < WS_END) { fprintf(stderr, "kernel_launch: unexpected shapes (n_in %d, out %d, ws %zu)\n", n_in, out_size, ws_size); grid = -1; return; }
        int dev = 0, cus = 0, per_cu = 0;
        if (hipGetDevice(&dev) != hipSuccess || hipDeviceGetAttribute(&cus, hipDeviceAttributeMultiprocessorCount, dev) != hipSuccess) { grid = -1; return; }
        if (hipFuncSetAttribute((const void*)mk_fwd, hipFuncAttributeMaxDynamicSharedMemorySize, LDS_BYTES) != hipSuccess) { fprintf(stderr, "kernel_launch: hipFuncSetAttribute failed\n"); grid = -1; return; }
        if (hipOccupancyMaxActiveBlocksPerMultiprocessor(&per_cu, (const void*)mk_fwd, 512, LDS_BYTES) != hipSuccess || per_cu < 1)
            fprintf(stderr, "kernel_launch: note: occupancy query reports %d blocks per CU\n", per_cu);
        (void)hipGetLastError();
        if (cus * 4 < (NTOK / 256) * (DM / 256)) { fprintf(stderr, "kernel_launch: %d CUs give a workgroup more than four output-GEMM units\n", cus); grid = -1; return; }
        grid = cus;
    }
    if (grid < 0) return;
    if (hipMemsetAsync((char*)d_ws + WS_CTL, 0, CTL_ZERO_BYTES, stream) != hipSuccess) return;
    Args a{};
    for (int i = 0; i < 26; ++i) a.in[i] = (const float*)d_in[i];
    a.out = (float*)d_out; a.ws = (unsigned char*)d_ws;
#if MK_N_LAUNCHES == 1
    a.ph_lo = 0; a.ph_hi = N_PHASES;
    hipLaunchKernelGGL(mk_fwd, dim3(grid), dim3(512), LDS_BYTES, stream, a);
#else
#ifndef MK_DUP_LAUNCH
#define MK_DUP_LAUNCH -1
#endif
    for (int p = 0; p < N_PHASES; ++p) { a.ph_lo = p; a.ph_hi = p + 1;
#ifndef MK_NREP
#define MK_NREP 2
#endif
#ifndef MK_SUB
#define MK_SUB 0
#endif
        for (int rep = 0; rep < (p == (MK_DUP_LAUNCH) ? (MK_NREP) : 1); ++rep) { a.sub = (p == (MK_DUP_LAUNCH) && rep + 1 < (MK_NREP)) ? (MK_SUB) : 0; hipLaunchKernelGGL(mk_fwd, dim3(grid), dim3(512), LDS_BYTES, stream, a); } }
#endif
}
```
